# Optimizing an MI355X kernel written in HIP

```python
import math
import jax, jax.numpy as jnp
from jax import lax
import numpy as np

D_MODEL = 1024
BATCH = 4
SEQ = 8192
DEPTH = 4

GRID_W = 64
CTX_LEN = 256
N_MIXERS = 2
NORM_EPS = 1e-6

MLA_HEADS = 8
QK_NOPE = 128
QK_ROPE = 64
V_DIM = 128
Q_LORA = 256
KV_LORA = 128
MLA_WIDTH = MLA_HEADS * V_DIM
MLA_IN_WIDTH = Q_LORA + KV_LORA + QK_ROPE + MLA_WIDTH
ROPE_AXIS_DIM = QK_ROPE // 2
ROPE_THETA = 10000.0
Q_BLOCK = 128

FOURIER_WIDTH = D_MODEL
FOURIER_GROUPS = 8
FOURIER_GROUP_DIM = FOURIER_WIDTH // FOURIER_GROUPS

N_MLA_LAYERS = (DEPTH + 1) // 2
N_FOURIER_LAYERS = DEPTH // 2
ADA_STD = 0.5 * D_MODEL ** -0.5

kernel_name = "hybrid_mla_fourier_gated_prefix_dit"


def rms_norm(x, g):
    xf = x.astype(jnp.float32)
    y = xf * lax.rsqrt(jnp.mean(xf * xf, axis=-1, keepdims=True) + NORM_EPS)
    return (y * g.astype(jnp.float32)).astype(x.dtype)


def axial_rope_tables(row, col):
    inv_freq = 1.0 / (ROPE_THETA ** (jnp.arange(0, ROPE_AXIS_DIM, 2, dtype=jnp.float32) / ROPE_AXIS_DIM))
    ang_r = row.astype(jnp.float32)[:, None] * inv_freq[None, :]
    ang_c = col.astype(jnp.float32)[:, None] * inv_freq[None, :]
    return jnp.cos(ang_r), jnp.sin(ang_r), jnp.cos(ang_c), jnp.sin(ang_c)


def _rotate(t, cos, sin):
    t1, t2 = jnp.split(t, 2, axis=-1)
    return jnp.concatenate([t1 * cos - t2 * sin, t2 * cos + t1 * sin], axis=-1)


def apply_axial_rope(t, tables):
    cos_r, sin_r, cos_c, sin_c = [a.astype(t.dtype)[None, :, None, :] for a in tables]
    t_r, t_c = jnp.split(t, 2, axis=-1)
    return jnp.concatenate([_rotate(t_r, cos_r, sin_r), _rotate(t_c, cos_c, sin_c)], axis=-1)


def mla_query(c_q, g_qa, w_qup):
    b, t, _ = c_q.shape
    q = (rms_norm(c_q, g_qa) @ w_qup).reshape(b, t, MLA_HEADS, QK_NOPE + QK_ROPE)
    return q[..., :QK_NOPE], q[..., QK_NOPE:]


def mla_keyvalue(c_kv, g_kva, w_kvup):
    b, t, _ = c_kv.shape
    kv = (rms_norm(c_kv, g_kva) @ w_kvup).reshape(b, t, MLA_HEADS, QK_NOPE + V_DIM)
    return kv[..., :QK_NOPE], kv[..., QK_NOPE:]


def assemble_keys(k_nope, k_pe):
    return jnp.concatenate([k_nope, jnp.broadcast_to(k_pe, k_nope.shape[:-1] + (QK_ROPE,))], axis=-1)


def dense_attention(q, k, v):
    scale = 1.0 / math.sqrt(QK_NOPE + QK_ROPE)
    s = jnp.einsum('bqhd,bkhd->bhqk', q, k).astype(jnp.float32) * scale
    p = jax.nn.softmax(s, axis=-1).astype(v.dtype)
    return jnp.einsum('bhqk,bkhd->bqhd', p, v)


def latent_attention(q, k_lat, v_lat, k_ctx, v_ctx):
    b, t, h, dk = q.shape
    k_all = jnp.concatenate([k_ctx, k_lat], axis=1)
    v_all = jnp.concatenate([v_ctx, v_lat], axis=1)
    nb = t // Q_BLOCK
    qb = q.reshape(b, nb, Q_BLOCK, h, dk).transpose(1, 0, 2, 3, 4)
    o = lax.map(lambda qblk: dense_attention(qblk, k_all, v_all), qb)
    return o.transpose(1, 0, 2, 3, 4).reshape(b, t, h * V_DIM)


def fourier_mix(u, w_in, w_out):
    proj = u @ w_in
    z, gate = proj[..., :FOURIER_WIDTH], proj[..., FOURIER_WIDTH:]
    b, t, _ = z.shape
    zg = z.reshape(b, t, FOURIER_GROUPS, FOURIER_GROUP_DIM).astype(jnp.float32)
    y = jnp.fft.fftn(zg, axes=(1, 3), norm="ortho").real.astype(u.dtype).reshape(b, t, FOURIER_WIDTH)
    return (y * jax.nn.silu(gate)) @ w_out


def ada_params(cond_act, w, b):
    mod = cond_act @ w + b
    return jnp.split(mod, 3, axis=-1)


def setup_inputs(seed: int = 0) -> dict:
    key = jax.random.key(seed)
    ks = jax.random.split(key, 16)
    n = jax.random.normal
    f32 = jnp.float32
    return {
        "x": n(ks[0], (BATCH, SEQ, D_MODEL), f32),
        "c": n(ks[1], (BATCH, D_MODEL), f32),
        "ctx": n(ks[2], (BATCH, CTX_LEN, D_MODEL), f32),
        "c_ctx": n(ks[3], (D_MODEL,), f32),
        "norm_g": 1.0 + 0.02 * n(ks[4], (DEPTH, D_MODEL), f32),
        "w_ada": ADA_STD * n(ks[5], (DEPTH, D_MODEL, 3 * D_MODEL), f32),
        "b_ada": 0.02 * n(ks[6], (DEPTH, 3 * D_MODEL), f32),
        "mla_w_in": D_MODEL ** -0.5 * n(ks[7], (N_MLA_LAYERS, D_MODEL, MLA_IN_WIDTH), f32),
        "mla_g_qa": 1.0 + 0.02 * n(ks[8], (N_MLA_LAYERS, Q_LORA), f32),
        "mla_w_qup": Q_LORA ** -0.5 * n(ks[9], (N_MLA_LAYERS, Q_LORA, MLA_HEADS * (QK_NOPE + QK_ROPE)), f32),
        "mla_g_kva": 1.0 + 0.02 * n(ks[10], (N_MLA_LAYERS, KV_LORA), f32),
        "mla_w_kvup": KV_LORA ** -0.5 * n(ks[11], (N_MLA_LAYERS, KV_LORA, MLA_HEADS * (QK_NOPE + V_DIM)), f32),
        "mla_w_out": MLA_WIDTH ** -0.5 * n(ks[12], (N_MLA_LAYERS, MLA_WIDTH, D_MODEL), f32),
        "fno_w_in": D_MODEL ** -0.5 * n(ks[13], (N_FOURIER_LAYERS, D_MODEL, 2 * FOURIER_WIDTH), f32),
        "fno_w_out": FOURIER_WIDTH ** -0.5 * n(ks[14], (N_FOURIER_LAYERS, FOURIER_WIDTH, D_MODEL), f32),
        "final_g": 1.0 + 0.02 * n(ks[15], (D_MODEL,), f32),
    }


def reference(x, c, ctx, c_ctx, norm_g, w_ada, b_ada, mla_w_in, mla_g_qa, mla_w_qup, mla_g_kva,
              mla_w_kvup, mla_w_out, fno_w_in, fno_w_out, final_g):
    n_tok = x.shape[1]
    rows = n_tok // GRID_W
    row = jnp.repeat(jnp.arange(rows, dtype=jnp.int32), GRID_W)
    col = jnp.tile(jnp.arange(GRID_W, dtype=jnp.int32), rows)
    rope = axial_rope_tables(row, col)

    act_lat = jax.nn.silu(c)
    act_ctx = jax.nn.silu(c_ctx)
    h_lat, h_ctx = x, ctx
    kv_lo, kv_hi = Q_LORA, Q_LORA + KV_LORA
    pe_hi = kv_hi + QK_ROPE

    for i in range(DEPTH):
        mixer = i % N_MIXERS
        idx = i // N_MIXERS
        ctx_later = any(j % N_MIXERS == 0 for j in range(i + 1, DEPTH))

        sh_l, sc_l, gt_l = ada_params(act_lat, w_ada[i], b_ada[i])
        u_lat = rms_norm(h_lat, norm_g[i]) * (1.0 + sc_l[:, None, :]) + sh_l[:, None, :]
        sh_c, sc_c, gt_c = ada_params(act_ctx, w_ada[i], b_ada[i])

        if mixer == 0:
            w_in = mla_w_in[idx]
            u_ctx = rms_norm(h_ctx, norm_g[i]) * (1.0 + sc_c) + sh_c
            p_lat = u_lat @ w_in
            qn_l, qp_l = mla_query(p_lat[..., :kv_lo], mla_g_qa[idx], mla_w_qup[idx])
            kn_l, v_l = mla_keyvalue(p_lat[..., kv_lo:kv_hi], mla_g_kva[idx], mla_w_kvup[idx])
            kp_l = apply_axial_rope(p_lat[..., None, kv_hi:pe_hi], rope)
            q_l = jnp.concatenate([qn_l, apply_axial_rope(qp_l, rope)], axis=-1)
            k_l = assemble_keys(kn_l, kp_l)
            if ctx_later:
                p_ctx = u_ctx @ w_in
            else:
                p_ctx = u_ctx @ w_in[:, kv_lo:pe_hi]
                p_ctx = jnp.concatenate([jnp.zeros(p_ctx.shape[:-1] + (kv_lo,), p_ctx.dtype), p_ctx], axis=-1) if False else p_ctx
            off = 0 if not ctx_later else kv_lo
            kn_c, v_c = mla_keyvalue(p_ctx[..., off:off + KV_LORA], mla_g_kva[idx], mla_w_kvup[idx])
            k_c = assemble_keys(kn_c, p_ctx[..., None, off + KV_LORA:off + KV_LORA + QK_ROPE])

            o_lat = latent_attention(q_l, k_l, v_l, k_c, v_c)
            y_lat = (o_lat * jax.nn.silu(p_lat[..., pe_hi:])) @ mla_w_out[idx]
            if ctx_later:
                qn_c, qp_c = mla_query(p_ctx[..., :kv_lo], mla_g_qa[idx], mla_w_qup[idx])
                q_c = jnp.concatenate([qn_c, qp_c], axis=-1)
                b_, t_c = h_ctx.shape[0], h_ctx.shape[1]
                o_ctx = dense_attention(q_c, k_c, v_c).reshape(b_, t_c, MLA_WIDTH)
                y_ctx = (o_ctx * jax.nn.silu(p_ctx[..., pe_hi:])) @ mla_w_out[idx]
                h_ctx = h_ctx + gt_c * y_ctx
            h_lat = h_lat + gt_l[:, None, :] * y_lat
        else:
            y_lat = fourier_mix(u_lat, fno_w_in[idx], fno_w_out[idx])
            if ctx_later:
                u_ctx = rms_norm(h_ctx, norm_g[i]) * (1.0 + sc_c) + sh_c
                h_ctx = h_ctx + gt_c * fourier_mix(u_ctx, fno_w_in[idx], fno_w_out[idx])
            h_lat = h_lat + gt_l[:, None, :] * y_lat

    return rms_norm(h_lat, final_g)
```

```cpp
#include <hip/hip_runtime.h>
#include <hip/hip_cooperative_groups.h>
#include <cstdio>
#include <cstdint>
namespace cg = cooperative_groups;

#ifndef MK_SINGLE
#define MK_SINGLE 1
#endif

#define LAS __attribute__((address_space(3)))
typedef unsigned short bf16_t;
typedef short bf16x8 __attribute__((ext_vector_type(8)));
typedef float f32x4 __attribute__((ext_vector_type(4)));
typedef float f32x16 __attribute__((ext_vector_type(16)));
typedef unsigned u32x4 __attribute__((ext_vector_type(4)));
typedef unsigned u32x2 __attribute__((ext_vector_type(2)));

constexpr int D = 1024, NB = 4, T = 8192, TC = 256, ML = NB * T, MC = NB * TC, M = ML + MC;
constexpr int H = 8, DQK = 192, DV = 128, TK = TC + T;
constexpr float EPS = 1e-6f;
constexpr float QSCALE = 0.07216878364870323f * 1.4426950408889634f;
constexpr int NPH = 22;

constexpr size_t MiB = 1u << 20;
constexpr size_t WS_MOD = 1 * MiB;
constexpr size_t WS_ROPE = 1 * MiB + 512 * 1024;
constexpr size_t WS_TW = 1 * MiB + 640 * 1024;
constexpr size_t WS_GS = 1 * MiB + 256 * 1024;
constexpr size_t WS_CV = 1 * MiB + 768 * 1024;
constexpr size_t WS_SSQH = 10 * MiB;
constexpr size_t WS_SSQ = 2 * MiB;
constexpr size_t WS_HC = 4 * MiB;
constexpr size_t WS_A1 = 8 * MiB;
constexpr size_t WS_A2 = 8 * MiB + 64 * 1024;
constexpr size_t WS_A3 = 8 * MiB + 256 * 1024;
constexpr size_t WS_FT = 9 * MiB;
constexpr size_t WS_WMLA = 16 * MiB;
constexpr size_t WMLA_IN = 0, WMLA_QUP = 3 * MiB, WMLA_KVUP = 4 * MiB, WMLA_OUT = 5 * MiB, WMLA_STRIDE = 8 * MiB;
constexpr size_t WS_WFNO = 32 * MiB;
constexpr size_t WFNO_IN = 0, WFNO_OUT = 6 * MiB, WFNO_STRIDE = 8 * MiB;
constexpr size_t WS_U = 64 * MiB;
constexpr size_t WS_G = 132 * MiB;
constexpr size_t WS_CQKV = 200 * MiB;
constexpr size_t WS_Q = 236 * MiB;
constexpr size_t WS_K = 336 * MiB;
constexpr size_t WS_V = 436 * MiB;
constexpr size_t WS_ZC = 236 * MiB, WS_ZS = 302 * MiB, WS_UR = 368 * MiB, WS_UI = 432 * MiB;
constexpr size_t WS_END = 504 * MiB;

constexpr int LDS_BYTES = 131072 + 2048;

typedef float f32x2_t __attribute__((ext_vector_type(2)));
typedef __bf16 bf16x2_t __attribute__((ext_vector_type(2)));
__device__ __forceinline__ unsigned cvt_pk_bf16(float lo, float hi) { const f32x2_t v = {lo, hi}; const bf16x2_t b = __builtin_convertvector(v, bf16x2_t); return __builtin_bit_cast(unsigned, b); }
__device__ __forceinline__ float bf_lo(unsigned u) { return __uint_as_float(u << 16); }
__device__ __forceinline__ float bf_hi(unsigned u) { return __uint_as_float(u & 0xffff0000u); }
__device__ __forceinline__ unsigned short f2bf(float f) { return (unsigned short)(cvt_pk_bf16(f, 0.f) & 0xffffu); }
__device__ __forceinline__ float silu_f(float x) { return x * __builtin_amdgcn_rcpf(1.f + __expf(-x)); }
__device__ __forceinline__ float shx(float v, int o, int lane) { return __int_as_float(__builtin_amdgcn_ds_bpermute((lane ^ o) << 2, __float_as_int(v))); }
__device__ __forceinline__ float wave_sum(float v, int lane) {
#pragma unroll
    for (int o = 1; o < 64; o <<= 1) v += shx(v, o, lane);
    return v;
}
#define LDS_WAIT() asm volatile("s_waitcnt lgkmcnt(0)" ::: "memory")
__device__ __forceinline__ f32x4 ld_nt4(const float* p) { return __builtin_nontemporal_load((const f32x4*)p); }
__device__ __forceinline__ void st_nt4(float* p, f32x4 v) { __builtin_nontemporal_store(v, (f32x4*)p); }
__device__ __forceinline__ float ld_nt1(const float* p) { return __builtin_nontemporal_load(p); }
__device__ __forceinline__ int opaque_tid() { int t; asm volatile("v_mov_b32 %0, %1" : "=v"(t) : "v"(threadIdx.x)); return t; }

struct Args { const float* in[16]; float* out; unsigned char* ws; int ph_lo, ph_hi; };
struct Ctx {
    const float* const* in; float* out; unsigned char* ws;
    int G, bid;
    __device__ __forceinline__ Ctx(const Args& a) { in = a.in; size_t z = 0; asm volatile("" : "+s"(z)); out = (float*)((unsigned char*)a.out + z); ws = a.ws + z; G = gridDim.x; bid = blockIdx.x; }
};


#define XB_TMO      128
#define XB_XCNT(j)  (256  + 64 * (j))
#define XB_XSUB(j)  (1280 + 64 * (j))
#define XB_XGEN(j)  (2304 + 64 * (j))
#define XB_TOP      3328
#define XB_TOPGEN   3392
#define XCD_BAR_WORDS 3456
#define XB_SPIN_CAP (1u << 22)
__device__ __forceinline__ unsigned xb_ld(unsigned* p)              { return __hip_atomic_load(p, __ATOMIC_RELAXED, __HIP_MEMORY_SCOPE_AGENT); }
__device__ __forceinline__ unsigned xb_add(unsigned* p, unsigned v) { return __hip_atomic_fetch_add(p, v, __ATOMIC_RELAXED, __HIP_MEMORY_SCOPE_AGENT); }
__device__ __forceinline__ unsigned xb_xcc_id() { return (unsigned)__builtin_amdgcn_s_getreg((3 << 11) | 20) & 0xFu; }
#define XB_SPIN(cond, bar) do { unsigned _sp = 0; while (cond) { __builtin_amdgcn_s_sleep(1); \
    if ((++_sp & 255u) == 0u) { if (xb_ld(&(bar)[XB_TMO])) break; if (_sp > XB_SPIN_CAP) { atomicAdd(&(bar)[XB_TMO], 1u); break; } } } } while (0)
struct XcdBarrier { unsigned* bar; unsigned x; volatile LAS unsigned* st; };
__device__ __forceinline__ XcdBarrier xcd_barrier_post(unsigned* bar, volatile LAS unsigned* st) {
    XcdBarrier b; b.bar = bar; b.x = xb_xcc_id(); b.st = st;
    if (threadIdx.x == 0) (void)xb_add(&bar[XB_XCNT(b.x)], 1u);
    return b;
}
__device__ __forceinline__ void xcd_barrier_complete(unsigned* bar, unsigned x, unsigned& nloc, unsigned& nx) {
    const unsigned G = gridDim.x * gridDim.y * gridDim.z;
    unsigned sum, cnt, mine, sp = 0u;
    for (;;) {
        sum = 0u; cnt = 0u; mine = 0u;
#pragma unroll
        for (unsigned j = 0; j < 16; ++j) { const unsigned c = xb_ld(&bar[XB_XCNT(j)]); sum += c; cnt += (c > 0u) ? 1u : 0u; mine = (j == x) ? c : mine; }
        if (sum == G) break;
        __builtin_amdgcn_s_sleep(1);
        if ((++sp & 255u) == 0u) { if (xb_ld(&bar[XB_TMO])) break; if (sp > XB_SPIN_CAP) { atomicAdd(&bar[XB_TMO], 1u); break; } }
    }
    nloc = mine > 0u ? mine : 1u; nx = cnt > 0u ? cnt : 1u;
}
__device__ __forceinline__ void xcd_barrier(const XcdBarrier& b) {
    asm volatile("s_waitcnt vmcnt(0)" ::: "memory");
    __syncthreads();
    if (threadIdx.x == 0) {
        unsigned* bar = b.bar;
        __builtin_amdgcn_s_waitcnt(0);
        unsigned nloc = b.st[0], nx = b.st[1];
        if (nloc == 0u) { xcd_barrier_complete(bar, b.x, nloc, nx); b.st[0] = nloc; b.st[1] = nx; }
        const unsigned old = xb_add(&bar[XB_XSUB(b.x)], 1u);
        const unsigned gen = old / nloc;
        if (old + 1u == (gen + 1u) * nloc) {
            __builtin_amdgcn_fence(__ATOMIC_RELEASE, "agent");
            asm volatile("s_waitcnt vmcnt(0)" ::: "memory");
            const unsigned og = xb_add(&bar[XB_TOP], 1u);
            const unsigned tg = og / nx;
            if (og + 1u == (tg + 1u) * nx) xb_add(&bar[XB_TOPGEN], 1u);
            else XB_SPIN(xb_ld(&bar[XB_TOPGEN]) == tg, bar);
            __builtin_amdgcn_fence(__ATOMIC_ACQUIRE, "agent");
            xb_add(&bar[XB_XGEN(b.x)], 1u);
            asm volatile("s_waitcnt vmcnt(0)" ::: "memory");
        } else {
            XB_SPIN(xb_ld(&bar[XB_XGEN(b.x)]) == gen, bar);
            __builtin_amdgcn_fence(__ATOMIC_ACQUIRE, "agent");
            asm volatile("s_waitcnt vmcnt(0)" ::: "memory");
        }
    }
    __syncthreads();
}

namespace pg8 {
constexpr int BM = 256, BK = 64, HALF = 128, HTB = HALF * BK * 2, NXCD = 8, WGM = 8;
__host__ __device__ __forceinline__ int lds_byte(int r, int c) { const int st = (r >> 4) * 2 + (c >> 5), rr = r & 15, cc = c & 31, ob = rr * 64 + cc * 2; return st * 1024 + (ob ^ (((ob >> 9) & 1) << 5)); }
__host__ __device__ __forceinline__ void stage_rc(int b, int& R, int& C) { const int st = b / 1024, sb = b % 1024, swz = sb ^ (((sb >> 9) & 1) << 5); R = (st >> 1) * 16 + swz / 64; C = (st & 1) * 32 + (swz % 64) / 2; }
__host__ __device__ __forceinline__ int perm32(int rho) { const int n = rho >> 4, i = rho & 15; return 8 * (i >> 2) + 4 * n + (i & 3); }
struct Unit { int pm, pn; };
struct Gemm { const bf16_t* A; const bf16_t* Bt; int M, N, K, lda, ldb; };
struct StaticOrder {
    int nM, nN, nwg, G, c;
    __device__ void init(int M_, int N_, int G_, int c_) { nM = M_ / BM; nN = N_ / BM; nwg = nM * nN; G = G_; c = c_; }
    __device__ bool next(int i, Unit& u) const {
        const long L = (long)i * G + c; if (L >= nwg) return false;
        int wgid = (int)L; { const int q = nwg / NXCD, r = nwg % NXCD, xcd = wgid % NXCD, off = wgid / NXCD; wgid = (xcd < r ? xcd * (q + 1) : r * (q + 1) + (xcd - r) * q) + off; }
        const int nig = WGM * nN, gid = wgid / nig, fm = gid * WGM, gsz = (nM - fm) < WGM ? (nM - fm) : WGM;
        u.pm = fm + ((wgid % nig) % gsz); u.pn = (wgid % nig) / gsz; return true;
    }
};

template <class Epi>
__device__ __forceinline__ void gemm_phase(LAS unsigned char* lds, const Gemm g, const StaticOrder& S, const Epi& E) {
    const int tid = opaque_tid(), wid = __builtin_amdgcn_readfirstlane(tid >> 6), lane = tid & 63, wr = wid >> 2, wc = wid & 3, fr = lane & 15, fq = lane >> 4;
    const int K = g.K, nt = K / BK;
    unsigned voffA[2], voffB[2];
#pragma unroll
    for (int i = 0; i < 2; ++i) { int R, C; stage_rc(tid * 16 + i * 8192, R, C); const int Rb = ((R & ~31) + perm32(R & 31));
        voffA[i] = (unsigned)(R * g.lda + C) * 2u; voffB[i] = (unsigned)(Rb * g.ldb + C) * 2u; }
    const size_t kstep = (size_t)(BK * 2);
    const size_t hstepA = (size_t)HALF * g.lda * 2, hstepB = (size_t)HALF * g.ldb * 2;
    const size_t tstepA = 2 * hstepA, tstepB = 2 * hstepB;
    const unsigned ldsw = (unsigned)wid * 1024u;
    const int aoff = lds_byte(wr * 64 + fr, fq * 8), boff = lds_byte(wc * 32 + fr, fq * 8);
#define PG8_SA(b, h) (((b) * 2 + (h)) * HTB)
#define PG8_SB(b, h) ((4 + (b) * 2 + (h)) * HTB)
#define PG8_STAGE(bufoff, gbase, voff) do { _Pragma("unroll") for (int _i = 0; _i < 2; ++_i) \
        __builtin_amdgcn_global_load_lds((const unsigned*)((const char*)(gbase) + (voff)[_i]), (LAS unsigned*)(lds + (bufoff) + ldsw + _i * 8192), 16, 0, 0); } while (0)
#define PG8_LDA(dst, b, h) do { _Pragma("unroll") for (int m = 0; m < 4; ++m) _Pragma("unroll") for (int k = 0; k < 2; ++k) dst[m][k] = *(const LAS bf16x8*)(lds + PG8_SA(b, h) + aoff + m * 2048 + k * 1024); } while (0)
#define PG8_LDB(dst, b, h) do { _Pragma("unroll") for (int n = 0; n < 2; ++n) _Pragma("unroll") for (int k = 0; k < 2; ++k) dst[n][k] = *(const LAS bf16x8*)(lds + PG8_SB(b, h) + boff + n * 2048 + k * 1024); } while (0)
#define PG8_MMA(ai, bj, At, Bt) do { __builtin_amdgcn_s_setprio(1); _Pragma("unroll") for (int m = 0; m < 4; ++m) _Pragma("unroll") for (int n = 0; n < 2; ++n) _Pragma("unroll") for (int k = 0; k < 2; ++k) \
        acc[ai][bj][m][n] = __builtin_amdgcn_mfma_f32_16x16x32_bf16(Bt[n][k], At[m][k], acc[ai][bj][m][n], 0, 0, 0); __builtin_amdgcn_s_setprio(0); } while (0)
#define PG8_WAIT_V(n) asm volatile("s_waitcnt vmcnt(" #n ")" ::: "memory")
#define PG8_WAIT_L(n) asm volatile("s_waitcnt lgkmcnt(" #n ")" ::: "memory")
#define PG8_BAR __builtin_amdgcn_s_barrier()
#define PG8_SCHED __builtin_amdgcn_sched_barrier(0)
    Unit cur, nxt; int ui = 0;
    if (!S.next(0, cur)) return;
    f32x4 acc[2][2][4][2];
#pragma unroll
    for (int a = 0; a < 2; ++a)
#pragma unroll
        for (int b = 0; b < 2; ++b)
#pragma unroll
            for (int m = 0; m < 4; ++m)
#pragma unroll
                for (int n = 0; n < 2; ++n) acc[a][b][m][n] = (f32x4){0.f, 0.f, 0.f, 0.f};
    bf16x8 At[4][2], B0[2][2], B1[2][2];
    const char* cA = (const char*)g.A + (size_t)cur.pm * tstepA; const char* cB = (const char*)g.Bt + (size_t)cur.pn * tstepB;
    PG8_STAGE(PG8_SB(0, 0), cB, voffB); PG8_STAGE(PG8_SB(0, 1), cB + hstepB, voffB); PG8_STAGE(PG8_SA(0, 0), cA, voffA); PG8_STAGE(PG8_SA(0, 1), cA + hstepA, voffA);
    if (wr == 1) PG8_BAR;
    PG8_WAIT_V(2); PG8_BAR;
    PG8_STAGE(PG8_SB(1, 0), cB + kstep, voffB); PG8_STAGE(PG8_SA(1, 0), cA + kstep, voffA); PG8_STAGE(PG8_SB(1, 1), cB + hstepB + kstep, voffB);
    PG8_WAIT_V(6); PG8_BAR;
    for (;;) {
        const bool has_next = S.next(ui + 1, nxt);
        const char* nA = has_next ? (const char*)g.A + (size_t)nxt.pm * tstepA : cA; const char* nB = has_next ? (const char*)g.Bt + (size_t)nxt.pn * tstepB : cB;
        for (int t = 0; t < nt; t += 2) {
            const bool last = (t == nt - 2);
            const char* a1 = cA + (size_t)(t + 1) * kstep;
            const char* a2 = last ? nA : cA + (size_t)(t + 2) * kstep; const char* b2 = last ? nB : cB + (size_t)(t + 2) * kstep;
            const char* a3 = a2 + kstep; const char* b3 = b2 + kstep;
            PG8_LDB(B0, 0, 0); PG8_LDB(B1, 0, 1); PG8_SCHED; PG8_LDA(At, 0, 0); PG8_STAGE(PG8_SA(1, 1), a1 + hstepA, voffA);
            PG8_WAIT_V(8); PG8_WAIT_L(0); PG8_BAR; PG8_MMA(0, 0, At, B0); PG8_MMA(0, 1, At, B1); PG8_BAR; PG8_SCHED;
            PG8_LDA(At, 0, 1); PG8_STAGE(PG8_SB(0, 0), b2, voffB); PG8_STAGE(PG8_SB(0, 1), b2 + hstepB, voffB); PG8_STAGE(PG8_SA(0, 0), a2, voffA);
            PG8_WAIT_V(8); PG8_WAIT_L(0); PG8_BAR; PG8_MMA(1, 0, At, B0); PG8_MMA(1, 1, At, B1); PG8_BAR; PG8_SCHED;
            PG8_LDB(B0, 1, 0); PG8_LDB(B1, 1, 1); PG8_SCHED; PG8_LDA(At, 1, 0); PG8_STAGE(PG8_SA(0, 1), a2 + hstepA, voffA);
            PG8_WAIT_V(8); PG8_WAIT_L(0); PG8_BAR; PG8_MMA(0, 0, At, B0); PG8_MMA(0, 1, At, B1); PG8_BAR; PG8_SCHED;
            PG8_LDA(At, 1, 1); PG8_STAGE(PG8_SB(1, 0), b3, voffB); PG8_STAGE(PG8_SB(1, 1), b3 + hstepB, voffB); PG8_STAGE(PG8_SA(1, 0), a3, voffA);
            PG8_WAIT_V(8); PG8_WAIT_L(0); PG8_BAR; PG8_MMA(1, 0, At, B0); PG8_MMA(1, 1, At, B1); PG8_BAR; PG8_SCHED;
        }
        if (wr == 0) PG8_BAR;
        { const int te = opaque_tid(); E(acc, cur, wr, wc, te & 15, (te >> 4) & 3); }
        if (!has_next) break;
#pragma unroll
        for (int a = 0; a < 2; ++a)
#pragma unroll
            for (int b = 0; b < 2; ++b)
#pragma unroll
                for (int m = 0; m < 4; ++m)
#pragma unroll
                    for (int n = 0; n < 2; ++n) acc[a][b][m][n] = (f32x4){0.f, 0.f, 0.f, 0.f};
        cur = nxt; cA = nA; cB = nB; ++ui;
        if (wr == 1) PG8_BAR;
    }
    PG8_WAIT_V(0);
    PG8_BAR;
#undef PG8_SA
#undef PG8_SB
#undef PG8_STAGE
#undef PG8_LDA
#undef PG8_LDB
#undef PG8_MMA
#undef PG8_WAIT_V
#undef PG8_WAIT_L
#undef PG8_BAR
#undef PG8_SCHED
}
}

typedef const f32x4 (&AccRef)[2][2][4][2];
__device__ __forceinline__ void store8(bf16_t* p, f32x4 v0, f32x4 v1) {
    u32x4 w; w.x = cvt_pk_bf16(v0[0], v0[1]); w.y = cvt_pk_bf16(v0[2], v0[3]); w.z = cvt_pk_bf16(v1[0], v1[1]); w.w = cvt_pk_bf16(v1[2], v1[3]);
    *(u32x4*)p = w;
}
__device__ __forceinline__ float sumsq8(f32x4 a, f32x4 b) { return (a[0] * a[0] + a[1] * a[1]) + (a[2] * a[2] + a[3] * a[3]) + (b[0] * b[0] + b[1] * b[1]) + (b[2] * b[2] + b[3] * b[3]); }
__device__ __forceinline__ void rope8(f32x4& v0, f32x4& v1, const float* cs) {
    const f32x4 c01 = *(const f32x4*)cs, c23 = *(const f32x4*)(cs + 4);
    f32x4 a, b;
    a[0] = v0[0] * c01[0] - v0[1] * c01[1]; a[1] = v0[1] * c01[0] + v0[0] * c01[1];
    a[2] = v0[2] * c01[2] - v0[3] * c01[3]; a[3] = v0[3] * c01[2] + v0[2] * c01[3];
    b[0] = v1[0] * c23[0] - v1[1] * c23[1]; b[1] = v1[1] * c23[0] + v1[0] * c23[1];
    b[2] = v1[2] * c23[2] - v1[3] * c23[3]; b[3] = v1[3] * c23[2] + v1[2] * c23[3];
    v0 = a; v1 = b;
}
__device__ __forceinline__ void row_key(int row, int& b, int& key) { if (row < ML) { b = row >> 13; key = TC + (row & (T - 1)); } else { const int mc = row - ML; b = mc >> 8; key = mc & (TC - 1); } }

__device__ __forceinline__ float row_rstd(const float* SSQH, int row) {
    const f32x4 a = *(const f32x4*)(SSQH + (unsigned)row * 16), b = *(const f32x4*)(SSQH + (unsigned)row * 16 + 4), c = *(const f32x4*)(SSQH + (unsigned)row * 16 + 8), d = *(const f32x4*)(SSQH + (unsigned)row * 16 + 12);
    const f32x4 t = (a + b) + (c + d);
    return __builtin_amdgcn_rsqf(((t[0] + t[1]) + (t[2] + t[3])) * (1.f / D) + EPS);
}
struct EpiMlaIn {
    bf16_t* CQKV; float* SSQ; bf16_t* Gt; bf16_t* Kb; const float* rope; const float* SSQH; const float* cv;
    __device__ __forceinline__ void operator()(AccRef acc, const pg8::Unit& u, int wr, int wc, int fr, int fq) const {
        const int row0 = u.pm * 256 + wr * 64 + fr;
        float rs8[8];
#pragma unroll
        for (int i = 0; i < 4; ++i) rs8[i] = row_rstd(SSQH, row0 + i * 16);
        int rowb = row0 + 128; asm volatile("" : "+v"(rowb) : "v"(rs8[0]), "v"(rs8[1]), "v"(rs8[2]), "v"(rs8[3]));
#pragma unroll
        for (int i = 4; i < 8; ++i) rs8[i] = row_rstd(SSQH, rowb + (i & 3) * 16);
        asm volatile("" :: "v"(rs8[4]), "v"(rs8[5]), "v"(rs8[6]), "v"(rs8[7]));
        const float* cvr = cv + ((u.pm * 256 < ML) ? (u.pm >> 5) : 4) * 3072 + u.pn * 256 + wc * 32 + 8 * fq;
        const f32x4 cv00 = *(const f32x4*)(cvr), cv01 = *(const f32x4*)(cvr + 4), cv10 = *(const f32x4*)(cvr + 128), cv11 = *(const f32x4*)(cvr + 132);
#pragma unroll
        for (int ai = 0; ai < 2; ++ai)
#pragma unroll
            for (int m = 0; m < 4; ++m) {
                __builtin_amdgcn_sched_barrier(0);
                const int row = row0 + ai * 128 + m * 16;
                const float rsn = rs8[ai * 4 + m];
                f32x4 av[2][2];
                av[0][0] = acc[ai][0][m][0] * rsn + cv00; av[0][1] = acc[ai][0][m][1] * rsn + cv01; av[1][0] = acc[ai][1][m][0] * rsn + cv10; av[1][1] = acc[ai][1][m][1] * rsn + cv11;
                if (u.pn == 0) {
                    float s = sumsq8(av[0][0], av[0][1]) + sumsq8(av[1][0], av[1][1]);
                    s += shx(s, 16, fr + 16 * fq); s += shx(s, 32, fr + 16 * fq);
                    if (fq == 0) SSQ[(unsigned)row * 8 + wc] = s;
                } else if (u.pn == 1) {
                    float s = sumsq8(av[0][0], av[0][1]);
                    s += shx(s, 16, fr + 16 * fq); s += shx(s, 32, fr + 16 * fq);
                    if (fq == 0) SSQ[(unsigned)row * 8 + 4 + wc] = s;
                }
#pragma unroll
                for (int bj = 0; bj < 2; ++bj) {
                    const int cbase = u.pn * 256 + bj * 128 + wc * 32, col8 = cbase + 8 * fq;
                    f32x4 v0 = av[bj][0], v1 = av[bj][1];
                    if (cbase < 384) { store8(CQKV + (unsigned)row * 512 + col8, v0, v1); }
                    else if (cbase < 448) {
                        store8(CQKV + (unsigned)row * 512 + col8, v0, v1);
                        const int half = (cbase - 384) >> 5;
                        if (row < ML) { const int t = row & (T - 1), pos = half ? (t & 63) : (t >> 6); rope8(v0, v1, rope + (pos * 16 + 4 * fq) * 2); }
                        int b, key; row_key(row, b, key);
                        u32x4 w; w.x = cvt_pk_bf16(v0[0], v0[1]); w.y = cvt_pk_bf16(v0[2], v0[3]); w.z = cvt_pk_bf16(v1[0], v1[1]); w.w = cvt_pk_bf16(v1[2], v1[3]);
                        bf16_t* kp = Kb + ((unsigned)(b * H) * TK + key) * DQK + 128 + half * 32 + 8 * fq;
#pragma unroll
                        for (int h = 0; h < H; ++h) *(u32x4*)(kp + (unsigned)h * TK * DQK) = w;
                    }
                    else if (cbase < 512) { unsigned z = 0u; asm volatile("" : "+v"(z)); *(u32x4*)(CQKV + (unsigned)row * 512 + col8) = (u32x4){z, z, z, z}; }
                    else {
                        f32x4 g0, g1;
#pragma unroll
                        for (int j = 0; j < 4; ++j) { g0[j] = silu_f(v0[j]); g1[j] = silu_f(v1[j]); }
                        store8(Gt + (unsigned)row * 1024 + (col8 - 512), g0, g1);
                    }
                }
            }
    }
};
struct EpiQup {
    bf16_t* Q; const float* SSQ; const float* rope;
    __device__ __forceinline__ void operator()(AccRef acc, const pg8::Unit& u, int wr, int wc, int fr, int fq) const {
        const int row0 = u.pm * 256 + wr * 64 + fr;
#pragma unroll
        for (int ai = 0; ai < 2; ++ai)
#pragma unroll
            for (int m = 0; m < 4; ++m) {
                __builtin_amdgcn_sched_barrier(0);
                const int row = row0 + ai * 128 + m * 16;
                const f32x4 sq = *(const f32x4*)(SSQ + (unsigned)row * 8);
                const float rs = QSCALE / sqrtf(((sq[0] + sq[1]) + (sq[2] + sq[3])) * (1.f / 256.f) + EPS);
#pragma unroll
                for (int bj = 0; bj < 2; ++bj) {
                    const int cbase = u.pn * 256 + bj * 128 + wc * 32;
                    f32x4 v0 = acc[ai][bj][m][0] * rs, v1 = acc[ai][bj][m][1] * rs;
                    int head, d;
                    if (cbase < 1024) { head = cbase >> 7; d = (cbase & 127) + 8 * fq; }
                    else { const int idx = (cbase - 1024) >> 5, half = idx & 1; head = idx >> 1; d = 128 + half * 32 + 8 * fq;
                        if (row < ML) { const int t = row & (T - 1), pos = half ? (t & 63) : (t >> 6); rope8(v0, v1, rope + (pos * 16 + 4 * fq) * 2); } }
                    store8(Q + ((unsigned)head * M + row) * DQK + d, v0, v1);
                }
            }
    }
};
struct EpiKVup {
    bf16_t* Kb; bf16_t* Vb; const float* SSQ;
    __device__ __forceinline__ void operator()(AccRef acc, const pg8::Unit& u, int wr, int wc, int fr, int fq) const {
        const int row0 = u.pm * 256 + wr * 64 + fr, head = u.pn;
#pragma unroll
        for (int ai = 0; ai < 2; ++ai)
#pragma unroll
            for (int m = 0; m < 4; ++m) {
                __builtin_amdgcn_sched_barrier(0);
                const int row = row0 + ai * 128 + m * 16;
                const f32x4 sq = *(const f32x4*)(SSQ + (unsigned)row * 8 + 4);
                const float rs = 1.f / sqrtf(((sq[0] + sq[1]) + (sq[2] + sq[3])) * (1.f / 128.f) + EPS);
                int b, key; row_key(row, b, key);
                const size_t kv = (unsigned)(b * H + head) * TK + key;
                store8(Kb + kv * DQK + wc * 32 + 8 * fq, acc[ai][0][m][0] * rs, acc[ai][0][m][1] * rs);
                store8(Vb + kv * DV + wc * 32 + 8 * fq, acc[ai][1][m][0] * rs, acc[ai][1][m][1] * rs);
            }
    }
};
struct EpiOut {
    const float* src_lat; const float* src_ctx; float* dst_lat; float* dst_ctx; const float* mod;
    const float* gs_next; bf16_t* Anext; float* SSQH;
    __device__ __forceinline__ void operator()(AccRef acc, const pg8::Unit& u, int wr, int wc, int fr, int fq) const {
        const int row0 = u.pm * 256 + wr * 64 + fr;
        const bool lat = u.pm * 256 < ML; const int r = lat ? (u.pm >> 5) : 4;
        const float* sb = lat ? src_lat + (unsigned)row0 * D : src_ctx + (unsigned)(row0 - ML) * D;
        float* db = lat ? dst_lat + (unsigned)row0 * D : dst_ctx + (unsigned)(row0 - ML) * D;
        const int c0 = u.pn * 256 + wc * 32 + 8 * fq;
        const float* gt = mod + r * 3072 + 2048 + c0;
        const f32x4 g00 = *(const f32x4*)(gt), g01 = *(const f32x4*)(gt + 4), g10 = *(const f32x4*)(gt + 128), g11 = *(const f32x4*)(gt + 132);
        f32x4 n00 = {1.f, 1.f, 1.f, 1.f}, n01 = n00, n10 = n00, n11 = n00;
        if (gs_next) { const float* gn = gs_next + r * 1024 + c0; n00 = *(const f32x4*)(gn); n01 = *(const f32x4*)(gn + 4); n10 = *(const f32x4*)(gn + 128); n11 = *(const f32x4*)(gn + 132); }
        f32x4 hc[4], hn[4];
        hc[0] = ld_nt4(sb + c0); hc[1] = ld_nt4(sb + c0 + 4); hc[2] = ld_nt4(sb + c0 + 128); hc[3] = ld_nt4(sb + c0 + 132);
#pragma unroll
        for (int i = 0; i < 8; ++i) {
            const int ai = i >> 2, m = i & 3, ro = (ai * 128 + m * 16) * D;
            if (i < 7) { const int rn = (((i + 1) >> 2) * 128 + ((i + 1) & 3) * 16) * D;
                hn[0] = ld_nt4(sb + rn + c0); hn[1] = ld_nt4(sb + rn + c0 + 4); hn[2] = ld_nt4(sb + rn + c0 + 128); hn[3] = ld_nt4(sb + rn + c0 + 132); }
            const f32x4 v00 = hc[0] + g00 * acc[ai][0][m][0], v01 = hc[1] + g01 * acc[ai][0][m][1], v10 = hc[2] + g10 * acc[ai][1][m][0], v11 = hc[3] + g11 * acc[ai][1][m][1];
            if (gs_next) { st_nt4(db + ro + c0, v00); st_nt4(db + ro + c0 + 4, v01); st_nt4(db + ro + c0 + 128, v10); st_nt4(db + ro + c0 + 132, v11); }
            else { *(f32x4*)(db + ro + c0) = v00; *(f32x4*)(db + ro + c0 + 4) = v01; *(f32x4*)(db + ro + c0 + 128) = v10; *(f32x4*)(db + ro + c0 + 132) = v11; }
            if (gs_next) {
                float ss = sumsq8(v00, v01) + sumsq8(v10, v11);
                const unsigned ao = (unsigned)(row0 + ai * 128 + m * 16) * 1024 + c0;
                store8(Anext + ao, v00 * n00, v01 * n01); store8(Anext + ao + 128, v10 * n10, v11 * n11);
                ss += shx(ss, 16, fr + 16 * fq); ss += shx(ss, 32, fr + 16 * fq);
                if (fq == 0) SSQH[(unsigned)(row0 + ai * 128 + m * 16) * 16 + u.pn * 4 + wc] = ss;
            }
#pragma unroll
            for (int q = 0; q < 4; ++q) hc[q] = hn[q];
        }
    }
};
struct EpiFnoIn {
    bf16_t* ZC; bf16_t* ZS; bf16_t* Gt; const float* SSQH; const float* cv;
    __device__ __forceinline__ void operator()(AccRef acc, const pg8::Unit& u, int wr, int wc, int fr, int fq) const {
        const int row0 = u.pm * 256 + wr * 64 + fr;
        float rs8[8];
#pragma unroll
        for (int i = 0; i < 4; ++i) rs8[i] = row_rstd(SSQH, row0 + i * 16);
        int rowb = row0 + 128; asm volatile("" : "+v"(rowb) : "v"(rs8[0]), "v"(rs8[1]), "v"(rs8[2]), "v"(rs8[3]));
#pragma unroll
        for (int i = 4; i < 8; ++i) rs8[i] = row_rstd(SSQH, rowb + (i & 3) * 16);
        asm volatile("" :: "v"(rs8[4]), "v"(rs8[5]), "v"(rs8[6]), "v"(rs8[7]));
        const float* cvr = cv + ((u.pm * 256 < ML) ? (u.pm >> 5) : 4) * 3072 + u.pn * 256 + wc * 32 + 8 * fq;
        const f32x4 cvq[2][2] = {{*(const f32x4*)(cvr), *(const f32x4*)(cvr + 4)}, {*(const f32x4*)(cvr + 128), *(const f32x4*)(cvr + 132)}};
#pragma unroll
        for (int ai = 0; ai < 2; ++ai)
#pragma unroll
            for (int m = 0; m < 4; ++m) {
                __builtin_amdgcn_sched_barrier(0);
                const int row = row0 + ai * 128 + m * 16;
                const float rsn = rs8[ai * 4 + m];
#pragma unroll
                for (int bj = 0; bj < 2; ++bj) {
                    const int col8 = u.pn * 256 + bj * 128 + wc * 32 + 8 * fq;
                    const f32x4 v0 = acc[ai][bj][m][0] * rsn + cvq[bj][0], v1 = acc[ai][bj][m][1] * rsn + cvq[bj][1];
                    if (u.pn < 4) store8(ZC + (unsigned)row * 1024 + col8, v0, v1);
                    else { f32x4 g0, g1;
#pragma unroll
                        for (int j = 0; j < 4; ++j) { g0[j] = silu_f(v0[j]); g1[j] = silu_f(v1[j]); }
                        store8(Gt + (unsigned)row * 1024 + (col8 - 1024), g0, g1); }
                }
            }
    }
};

__device__ __forceinline__ int rope_src(int j) { const int half = j >> 5, r = j & 31; return half * 32 + (r & 1) * 16 + (r >> 1); }
__device__ __forceinline__ int src_col(int kind, int n) {
    if (kind == 1) { if (n < 384) return n; if (n < 448) return 384 + rope_src(n - 384); if (n < 512) return -1; return n - 64; }
    if (kind == 2) { if (n < 1024) return (n >> 7) * 192 + (n & 127); const int mm = n - 1024; return (mm >> 6) * 192 + 128 + rope_src(mm & 63); }
    if (kind == 3) return 1024 + n;
    return n;
}
__device__ __forceinline__ void transpose_item(const float* W, int K, int Nsrc, bf16_t* WT, int Ndst, const float* gain, int kind, LAS float* scr, int item, int lane) {
    const int nblk = Ndst / 32, kb = item / nblk, nb = item % nblk, k0 = 64 * kb, n0 = 32 * nb;
    const int sc = src_col(kind, n0 + (lane & 31));
#pragma unroll
    for (int i = 0; i < 32; ++i) { const int kk = 2 * i + (lane >> 5);
        float v = (sc >= 0) ? ld_nt1(W + (size_t)(k0 + kk) * Nsrc + sc) : 0.f;
        if (gain) v *= gain[k0 + kk];
        scr[kk * 33 + (lane & 31)] = v; }
    LDS_WAIT(); asm volatile("" ::: "memory");
    const int c = lane & 7;
#pragma unroll
    for (int j = 0; j < 4; ++j) { const int n = (lane >> 3) + 8 * j; const LAS float* s = scr + (8 * c) * 33 + n;
        u32x4 o; o.x = cvt_pk_bf16(s[0 * 33], s[1 * 33]); o.y = cvt_pk_bf16(s[2 * 33], s[3 * 33]); o.z = cvt_pk_bf16(s[4 * 33], s[5 * 33]); o.w = cvt_pk_bf16(s[6 * 33], s[7 * 33]);
        *(u32x4*)(WT + (size_t)(n0 + n) * K + k0 + 8 * c) = o; }
    LDS_WAIT(); asm volatile("" ::: "memory");
}

__device__ __forceinline__ void phase_prologue(const Ctx& X, LAS unsigned char* lds) {
    const int tid_ = opaque_tid(), lane_ = tid_ & 63, wave_ = __builtin_amdgcn_readfirstlane(tid_ >> 6); (void)lane_; (void)wave_;

    unsigned char* ws = X.ws;
    {
        LAS float* scr = (LAS float*)(lds + wave_ * 8704);
        const int gw = X.bid * 8 + wave_, NGW = X.G * 8;
        constexpr int I_IN = 16 * 48, I_QUP = 4 * 48, I_KV = 2 * 64, I_OUT = 16 * 32, I_MLA = I_IN + I_QUP + I_KV + I_OUT, I_FIN = 16 * 64, I_FNO = I_FIN + I_OUT;
        constexpr int NIT = 2 * I_MLA + 2 * I_FNO;
        for (int it = gw; it < NIT; it += NGW) {
            int r = it;
            if (r < 2 * I_MLA) {
                const int l = r / I_MLA; r -= l * I_MLA;
                unsigned char* wb = ws + WS_WMLA + l * WMLA_STRIDE;
                if (r < I_IN) { transpose_item(X.in[7] + (size_t)l * 1024 * 1472, 1024, 1472, (bf16_t*)(wb + WMLA_IN), 1536, nullptr, 1, scr, r, lane_); continue; } r -= I_IN;
                if (r < I_QUP) { transpose_item(X.in[9] + (size_t)l * 256 * 1536, 256, 1536, (bf16_t*)(wb + WMLA_QUP), 1536, X.in[8] + l * 256, 2, scr, r, lane_); continue; } r -= I_QUP;
                if (r < I_KV) { transpose_item(X.in[11] + (size_t)l * 128 * 2048, 128, 2048, (bf16_t*)(wb + WMLA_KVUP), 2048, X.in[10] + l * 128, 0, scr, r, lane_); continue; } r -= I_KV;
                transpose_item(X.in[12] + (size_t)l * 1024 * 1024, 1024, 1024, (bf16_t*)(wb + WMLA_OUT), 1024, nullptr, 0, scr, r, lane_);
            } else {
                r -= 2 * I_MLA; const int l = r / I_FNO; r -= l * I_FNO;
                unsigned char* wb = ws + WS_WFNO + l * WFNO_STRIDE;
                if (r < I_FIN) { transpose_item(X.in[13] + (size_t)l * 1024 * 2048, 1024, 2048, (bf16_t*)(wb + WFNO_IN), 2048, nullptr, 0, scr, r, lane_); continue; } r -= I_FIN;
                transpose_item(X.in[14] + (size_t)l * 1024 * 1024, 1024, 1024, (bf16_t*)(wb + WFNO_OUT), 1024, nullptr, 0, scr, r, lane_);
            }
        }
    }
    __syncthreads();
    constexpr int NB_ZF = 0, NB_MOD = 4 * 48;
    constexpr int TAB_ROPE = 2048, TAB_TW = 8192, TAB_A1 = 16384, TAB_A2 = 32768, TAB_A3 = 131072, TAB_FT = 32768, TAB_ALL = TAB_ROPE + TAB_TW + TAB_A1 + TAB_A2 + TAB_A3 + TAB_FT;
    constexpr int NB_TAB = (TAB_ALL + 4095) / 4096;
    for (int it = X.bid; it < NB_ZF + NB_MOD + NB_TAB; it += X.G) {
        if (it < NB_ZF) {
            const int l = it >> 8, kb = (it >> 3) & 31, g = it & 7, k0 = kb * 32;
            LAS float* Wt = (LAS float*)lds; LAS float* cs = Wt + 32 * 129; LAS float* sn = cs + 128;
            const float* W = X.in[13] + (size_t)l * 1024 * 2048;
            for (int i = 0; i < 8; ++i) { const int idx = tid_ + 512 * i, kk = idx >> 7, c = idx & 127; Wt[kk * 129 + c] = W[(size_t)(k0 + kk) * 2048 + g * 128 + c]; }
            if (tid_ < 128) { cs[tid_] = cospif(tid_ * (1.f / 64.f)); sn[tid_] = sinpif(tid_ * (1.f / 64.f)); }
            __syncthreads();
            bf16_t* WT = (bf16_t*)(ws + WS_WFNO + l * WFNO_STRIDE + WFNO_IN);
            const int kk = tid_ & 31, k2b = tid_ >> 5;
            for (int j = 0; j < 8; ++j) { const int k2 = k2b + 16 * j; float ac = 0.f, as = 0.f;
                for (int c = 0; c < 128; ++c) { const float w = Wt[kk * 129 + c]; const int ix = (c * k2) & 127; ac += w * cs[ix]; as += w * sn[ix]; }
                WT[(size_t)(g * 128 + k2) * 1024 + k0 + kk] = f2bf(ac); WT[(size_t)(1024 + g * 128 + k2) * 1024 + k0 + kk] = f2bf(as); }
            __syncthreads();
        } else if (it < NB_ZF + NB_MOD) {
            const int r0 = it - NB_ZF, l = r0 / 48, chunk = r0 % 48;
            LAS float* act = (LAS float*)lds; LAS float* red = act + 5 * 1024;
            for (int i = tid_; i < 5 * 1024; i += 512) { const float v = (i < 4096) ? X.in[1][i] : X.in[3][i - 4096]; act[i] = silu_f(v); }
            __syncthreads();
            const int cq4 = tid_ & 15, kg = tid_ >> 4;
            const float* w = X.in[5] + (size_t)l * 1024 * 3072 + chunk * 64 + cq4 * 4;
            f32x4 a0 = {0.f, 0.f, 0.f, 0.f}, a1 = a0, a2 = a0, a3 = a0, a4 = a0;
#pragma unroll 1
            for (int hf = 0; hf < 2; ++hf) {
                f32x4 wv[16];
#pragma unroll
                for (int k = 0; k < 16; ++k) wv[k] = ld_nt4(w + (size_t)(kg * 32 + hf * 16 + k) * 3072);
#pragma unroll
                for (int k = 0; k < 16; ++k) { const int kk = kg * 32 + hf * 16 + k;
                    a0 += wv[k] * act[kk]; a1 += wv[k] * act[1024 + kk]; a2 += wv[k] * act[2048 + kk]; a3 += wv[k] * act[3072 + kk]; a4 += wv[k] * act[4096 + kk]; }
            }
            *(LAS f32x4*)(red + (kg * 5 + 0) * 64 + cq4 * 4) = a0; *(LAS f32x4*)(red + (kg * 5 + 1) * 64 + cq4 * 4) = a1; *(LAS f32x4*)(red + (kg * 5 + 2) * 64 + cq4 * 4) = a2;
            *(LAS f32x4*)(red + (kg * 5 + 3) * 64 + cq4 * 4) = a3; *(LAS f32x4*)(red + (kg * 5 + 4) * 64 + cq4 * 4) = a4;
            __syncthreads();
            if (tid_ < 320) { const int r = tid_ >> 6, c2 = tid_ & 63; float s = X.in[6][l * 3072 + chunk * 64 + c2];
                for (int q = 0; q < 32; ++q) s += red[(q * 5 + r) * 64 + c2];
                ((float*)(ws + WS_MOD))[(l * 5 + r) * 3072 + chunk * 64 + c2] = s;
                if (chunk >= 16 && chunk < 32) { const int cc = (chunk - 16) * 64 + c2; ((float*)(ws + WS_GS))[(l * 5 + r) * 1024 + cc] = X.in[4][l * 1024 + cc] * (1.f + s); } }
            __syncthreads();
        } else {
            const int base = (it - NB_ZF - NB_MOD) * 4096;
            for (int i = 0; i < 8; ++i) {
                int idx = base + tid_ + 512 * i; if (idx >= TAB_ALL) break;
                if (idx < TAB_ROPE) { const int pos = idx >> 4, j = idx & 15; const float inv = 1.0f / powf(10000.0f, (float)(2 * j) / 32.0f); const float ang = (float)pos * inv;
                    ((float*)(ws + WS_ROPE))[idx * 2] = cosf(ang); ((float*)(ws + WS_ROPE))[idx * 2 + 1] = sinf(ang); continue; }
                idx -= TAB_ROPE;
                if (idx < TAB_TW) { const int t2 = idx >> 6, k1 = idx & 63; const float x = (float)(t2 * k1) * (1.f / 4096.f);
                    ((float*)(ws + WS_TW))[idx * 2] = cospif(x); ((float*)(ws + WS_TW))[idx * 2 + 1] = sinpif(x); continue; }
                idx -= TAB_TW;
                if (idx < TAB_A1) { const int row = idx >> 7, k = idx & 127, k1 = row & 63, e = k & 63;
                    const int t1 = 32 * (e >> 5) + 16 * ((e >> 4) & 1) + 8 * ((e & 7) >> 2) + 4 * ((e >> 3) & 1) + (e & 3); const float x = (float)((k1 * t1) & 63) * (1.f / 32.f);
                    const float c = cospif(x), s = sinpif(x); float v;
                    if (row < 64) v = (k < 64) ? c : -s; else v = (k < 64) ? -s : -c;
                    ((bf16_t*)(ws + WS_A1))[idx] = f2bf(v); continue; }
                idx -= TAB_A1;
                if (idx < TAB_A2) { const int k2 = idx >> 8, k = idx & 255, t2 = k & 127; const float x = (float)((k2 * t2) & 127) * (1.f / 64.f);
                    ((bf16_t*)(ws + WS_A2))[idx] = f2bf(k < 128 ? cospif(x) : sinpif(x)); continue; }
                idx -= TAB_A2;
                if (idx < TAB_A3) { const int kk = idx >> 9, k = idx & 511, t = k & 255; const float x = (float)((kk * t) & 255) * (1.f / 128.f);
                    ((bf16_t*)(ws + WS_A3))[idx] = f2bf(k < 256 ? cospif(x) : -sinpif(x)); continue; }
                idx -= TAB_A3;
                { const int n = idx >> 7, c = idx & 127, k2 = n & 127; const float x = (float)((c * k2) & 127) * (1.f / 64.f);
                    ((bf16_t*)(ws + WS_FT))[idx] = f2bf(n < 128 ? cospif(x) : sinpif(x)); }
            }
        }
    }
}

__device__ __forceinline__ void phase_norm(const Ctx& X, int layer, const float* src_lat, const float* src_ctx, int rows) {
    const int tid_ = opaque_tid(), lane_ = tid_ & 63, wave_ = __builtin_amdgcn_readfirstlane(tid_ >> 6);
    const float* gs = (const float*)(X.ws + WS_GS) + layer * 5 * 1024;
    bf16_t* U = (bf16_t*)(X.ws + WS_U); float* SSQH = (float*)(X.ws + WS_SSQH);
    const int gw = X.bid * 8 + wave_, NGW = X.G * 8;
    for (int it = gw; it < 2 * 1536 + 2 * 2048; it += NGW) {
        int l, n, N; const bf16_t* Wt;
        if (it < 3072) { const int li = it / 1536; n = it % 1536; l = 2 * li; N = 1536; Wt = (const bf16_t*)(X.ws + WS_WMLA + li * WMLA_STRIDE + WMLA_IN); }
        else { const int q = it - 3072, li = q / 2048; n = q % 2048; l = 2 * li + 1; N = 2048; Wt = (const bf16_t*)(X.ws + WS_WFNO + li * WFNO_STRIDE + WFNO_IN); }
        (void)N;
        const u32x4 w0 = *(const u32x4*)(Wt + (size_t)n * 1024 + lane_ * 16), w1 = *(const u32x4*)(Wt + (size_t)n * 1024 + lane_ * 16 + 8);
        const float wf[16] = {bf_lo(w0.x), bf_hi(w0.x), bf_lo(w0.y), bf_hi(w0.y), bf_lo(w0.z), bf_hi(w0.z), bf_lo(w0.w), bf_hi(w0.w),
                              bf_lo(w1.x), bf_hi(w1.x), bf_lo(w1.y), bf_hi(w1.y), bf_lo(w1.z), bf_hi(w1.z), bf_lo(w1.w), bf_hi(w1.w)};
        const float* sh = (const float*)(X.ws + WS_MOD) + l * 5 * 3072 + lane_ * 16;
#pragma unroll
        for (int r = 0; r < 5; ++r) { float acc = 0.f;
#pragma unroll
            for (int k = 0; k < 16; ++k) acc += sh[r * 3072 + k] * wf[k];
            acc = wave_sum(acc, lane_);
            if (lane_ == 0) ((float*)(X.ws + WS_CV))[(l * 5 + r) * 3072 + n] = acc; }
    }
    f32x4 nx[4];
    if (gw < rows) { const float* row = (gw < ML) ? src_lat + (size_t)gw * D : src_ctx + (size_t)(gw - ML) * D;
#pragma unroll
        for (int j = 0; j < 4; ++j) nx[j] = ld_nt4(row + 4 * lane_ + 256 * j); }
    for (int m = gw; m < rows; m += NGW) {
        const float* gr = gs + ((m < ML) ? (m >> 13) : 4) * 1024;
        f32x4 cu[4];
#pragma unroll
        for (int j = 0; j < 4; ++j) cu[j] = nx[j];
        if (m + NGW < rows) { const int m2 = m + NGW; const float* row2 = (m2 < ML) ? src_lat + (size_t)m2 * D : src_ctx + (size_t)(m2 - ML) * D;
#pragma unroll
            for (int j = 0; j < 4; ++j) nx[j] = ld_nt4(row2 + 4 * lane_ + 256 * j); }
        float s = 0.f;
#pragma unroll
        for (int j = 0; j < 4; ++j) { const int c = 4 * lane_ + 256 * j; const f32x4 v = cu[j]; s += (v[0] * v[0] + v[1] * v[1]) + (v[2] * v[2] + v[3] * v[3]);
            const f32x4 o = v * *(const f32x4*)(gr + c);
            u32x2 w; w.x = cvt_pk_bf16(o[0], o[1]); w.y = cvt_pk_bf16(o[2], o[3]);
            *(u32x2*)(U + (size_t)m * D + c) = w; }
        s = wave_sum(s, lane_);
        if (lane_ < 16) SSQH[(size_t)m * 16 + lane_] = (lane_ == 0) ? s : 0.f;
    }
}
__device__ __forceinline__ void phase_final(const Ctx& X) {
    const int tid_ = opaque_tid(), lane_ = tid_ & 63, wave_ = __builtin_amdgcn_readfirstlane(tid_ >> 6); (void)lane_; (void)wave_;

    const float* g = X.in[15];
    const int gw = X.bid * 8 + wave_, NGW = X.G * 8;
    f32x4 nx[4];
    if (gw < ML) {
#pragma unroll
        for (int j = 0; j < 4; ++j) nx[j] = ld_nt4(X.out + (size_t)gw * D + 4 * lane_ + 256 * j); }
    for (int m = gw; m < ML; m += NGW) {
        float* row = X.out + (size_t)m * D;
        f32x4 v[4]; float s = 0.f;
#pragma unroll
        for (int j = 0; j < 4; ++j) v[j] = nx[j];
        if (m + NGW < ML) {
#pragma unroll
            for (int j = 0; j < 4; ++j) nx[j] = ld_nt4(X.out + (size_t)(m + NGW) * D + 4 * lane_ + 256 * j); }
#pragma unroll
        for (int j = 0; j < 4; ++j) s += (v[j][0] * v[j][0] + v[j][1] * v[j][1]) + (v[j][2] * v[j][2] + v[j][3] * v[j][3]);
        const float rstd = 1.f / sqrtf(wave_sum(s, lane_) * (1.f / D) + EPS);
#pragma unroll
        for (int j = 0; j < 4; ++j) { const int c = 4 * lane_ + 256 * j; const f32x4 gg = *(const f32x4*)(g + c); st_nt4(row + c, v[j] * rstd * gg); }
    }
}

__device__ __forceinline__ void phase_attn_naive(const Ctx& X, LAS unsigned char* lds, bool with_ctx) {
    const int tid_ = opaque_tid(), lane_ = tid_ & 63, wave_ = __builtin_amdgcn_readfirstlane(tid_ >> 6); (void)lane_; (void)wave_;

    LAS unsigned* Qs = (LAS unsigned*)lds;
    LAS unsigned* Ks = Qs + 128 * 97;
    LAS unsigned* Vs = Ks + 64 * 97;
    LAS float* Ps = (LAS float*)(Vs + 64 * 64);
    const bf16_t* Qg = (const bf16_t*)(X.ws + WS_Q); const bf16_t* Kg = (const bf16_t*)(X.ws + WS_K); const bf16_t* Vg = (const bf16_t*)(X.ws + WS_V);
    const bf16_t* Gt = (const bf16_t*)(X.ws + WS_G); bf16_t* OG = (bf16_t*)(X.ws + WS_U);
    const int tid = tid_, tx = tid & 15, ty = tid >> 4;
    const int NU = 2048 + (with_ctx ? 64 : 0);
    for (int unit = X.bid; unit < NU; unit += X.G) {
        int b, h, row0, nkeys;
        if (unit < 2048) { b = unit >> 9; h = (unit >> 6) & 7; row0 = b * T + (unit & 63) * 128; nkeys = TK; }
        else { const int uc = unit - 2048; b = uc >> 4; h = (uc >> 1) & 7; row0 = ML + b * TC + (uc & 1) * 128; nkeys = TC; }
        const unsigned* Qp = (const unsigned*)(Qg + ((size_t)h * M + row0) * DQK);
        const unsigned* Kp = (const unsigned*)(Kg + (size_t)(b * H + h) * TK * DQK);
        const unsigned* Vp = (const unsigned*)(Vg + (size_t)(b * H + h) * TK * DV);
        __syncthreads();
        for (int i = 0; i < 24; ++i) { const int idx = tid + 512 * i, r = idx / 96, c = idx % 96; Qs[r * 97 + c] = Qp[(size_t)r * 96 + c]; }
        float mi[4], li[4], o[4][8];
#pragma unroll
        for (int i = 0; i < 4; ++i) { mi[i] = -1e30f; li[i] = 0.f;
#pragma unroll
            for (int c = 0; c < 8; ++c) o[i][c] = 0.f; }
        for (int kt = 0; kt < nkeys; kt += 64) {
            __syncthreads();
            for (int i = 0; i < 12; ++i) { const int idx = tid + 512 * i, r = idx / 96, c = idx % 96; Ks[r * 97 + c] = Kp[(size_t)(kt + r) * 96 + c]; }
            for (int i = 0; i < 8; ++i) { const int idx = tid + 512 * i; Vs[idx] = Vp[(size_t)kt * 64 + idx]; }
            __syncthreads();
            float s[4][4];
#pragma unroll
            for (int i = 0; i < 4; ++i)
#pragma unroll
                for (int j = 0; j < 4; ++j) s[i][j] = 0.f;
            for (int c = 0; c < 96; ++c) {
                unsigned q[4], k[4];
#pragma unroll
                for (int i = 0; i < 4; ++i) { q[i] = Qs[(4 * ty + i) * 97 + c]; k[i] = Ks[(4 * tx + i) * 97 + c]; }
#pragma unroll
                for (int i = 0; i < 4; ++i)
#pragma unroll
                    for (int j = 0; j < 4; ++j) s[i][j] += bf_lo(q[i]) * bf_lo(k[j]) + bf_hi(q[i]) * bf_hi(k[j]);
            }
#pragma unroll
            for (int i = 0; i < 4; ++i) {
                float mx = fmaxf(fmaxf(s[i][0], s[i][1]), fmaxf(s[i][2], s[i][3]));
                mx = fmaxf(mx, shx(mx, 1, lane_)); mx = fmaxf(mx, shx(mx, 2, lane_)); mx = fmaxf(mx, shx(mx, 4, lane_)); mx = fmaxf(mx, shx(mx, 8, lane_));
                const float mn = fmaxf(mi[i], mx), alpha = exp2f(mi[i] - mn);
                float rs = 0.f;
#pragma unroll
                for (int j = 0; j < 4; ++j) { const float p = exp2f(s[i][j] - mn); rs += p; Ps[(4 * ty + i) * 65 + 4 * tx + j] = p; }
                rs += shx(rs, 1, lane_); rs += shx(rs, 2, lane_); rs += shx(rs, 4, lane_); rs += shx(rs, 8, lane_);
                li[i] = li[i] * alpha + rs; mi[i] = mn;
#pragma unroll
                for (int c = 0; c < 8; ++c) o[i][c] *= alpha;
            }
            __syncthreads();
            for (int key = 0; key < 64; ++key) {
                const u32x4 vv = *(const LAS u32x4*)(Vs + key * 64 + tx * 4);
                float vf[8] = {bf_lo(vv.x), bf_hi(vv.x), bf_lo(vv.y), bf_hi(vv.y), bf_lo(vv.z), bf_hi(vv.z), bf_lo(vv.w), bf_hi(vv.w)};
#pragma unroll
                for (int i = 0; i < 4; ++i) { const float p = Ps[(4 * ty + i) * 65 + key];
#pragma unroll
                    for (int c = 0; c < 8; ++c) o[i][c] += p * vf[c]; }
            }
        }
#pragma unroll
        for (int i = 0; i < 4; ++i) {
            const float inv = 1.f / li[i]; const size_t off = (size_t)(row0 + 4 * ty + i) * 1024 + h * 128 + 8 * tx;
            const u32x4 gg = *(const u32x4*)(Gt + off);
            u32x4 w;
            w.x = cvt_pk_bf16(o[i][0] * inv * bf_lo(gg.x), o[i][1] * inv * bf_hi(gg.x)); w.y = cvt_pk_bf16(o[i][2] * inv * bf_lo(gg.y), o[i][3] * inv * bf_hi(gg.y));
            w.z = cvt_pk_bf16(o[i][4] * inv * bf_lo(gg.z), o[i][5] * inv * bf_hi(gg.z)); w.w = cvt_pk_bf16(o[i][6] * inv * bf_lo(gg.w), o[i][7] * inv * bf_hi(gg.w));
            *(u32x4*)(OG + off) = w;
        }
    }
}


namespace att {
typedef short s16x4 __attribute__((ext_vector_type(4)));
constexpr int SHM_V = 64 * 128 * 2, SHM_K = 64 * 192 * 2, OFF_V = 0, OFF_K = 3 * SHM_V, OFF_WS = OFF_K + 2 * SHM_K;
constexpr float THR2 = 8.f;
#define KSWZ(row, colB) ((((colB) >> 5) * 2048) + (row) * 32 + (((((colB) >> 4) & 1) ^ (((row) >> 3) & 1)) << 4))
#define SBAR() __builtin_amdgcn_sched_barrier(0)
__device__ __forceinline__ int crow(int r, int hi) { return (r & 3) + 8 * (r >> 2) + 4 * hi; }
__device__ __forceinline__ void partialSM(f32x16& p0, f32x16& p1, float& m_reg, float& mn, float& alpha) {
    float pmax = p0[0];
#pragma unroll
    for (int r = 1; r < 16; ++r) pmax = fmaxf(pmax, p0[r]);
#pragma unroll
    for (int r = 0; r < 16; ++r) pmax = fmaxf(pmax, p1[r]);
    { auto rr = __builtin_amdgcn_permlane32_swap(__float_as_uint(pmax), __float_as_uint(pmax), false, false);
      pmax = fmaxf(__uint_as_float(rr[0]), __uint_as_float(rr[1])); }
    if (__builtin_expect(__all(pmax - m_reg <= THR2), 1)) { mn = m_reg; alpha = 1.f; }
    else { mn = fmaxf(m_reg, pmax); alpha = __builtin_amdgcn_exp2f(m_reg - mn); m_reg = mn; }
#pragma unroll
    for (int r = 0; r < 16; ++r) p0[r] = p0[r] - mn;
#pragma unroll
    for (int r = 0; r < 16; ++r) p1[r] = p1[r] - mn;
#pragma unroll
    for (int r = 0; r < 16; ++r) p0[r] = __builtin_amdgcn_exp2f(p0[r]);
}
__device__ __forceinline__ void finishSM(f32x16& p0, f32x16& p1, float alpha, float& l_reg, bf16x8& pa0, bf16x8& pa1, bf16x8& pa2, bf16x8& pa3) {
#pragma unroll
    for (int r = 0; r < 16; ++r) p1[r] = __builtin_amdgcn_exp2f(p1[r]);
    float ps = 0;
#pragma unroll
    for (int r = 0; r < 16; ++r) ps += p0[r];
#pragma unroll
    for (int r = 0; r < 16; ++r) ps += p1[r];
    { auto rr = __builtin_amdgcn_permlane32_swap(__float_as_uint(ps), __float_as_uint(ps), false, false);
      ps = __uint_as_float(rr[0]) + __uint_as_float(rr[1]); }
    l_reg = l_reg * alpha + ps;
#define PK4(P, BASE, OUT) do { unsigned a0 = cvt_pk_bf16(P[BASE + 0], P[BASE + 1]), a1 = cvt_pk_bf16(P[BASE + 2], P[BASE + 3]);   \
    unsigned b0 = cvt_pk_bf16(P[BASE + 4], P[BASE + 5]), b1 = cvt_pk_bf16(P[BASE + 6], P[BASE + 7]);                              \
    auto r0 = __builtin_amdgcn_permlane32_swap(a0, b0, false, false); auto r1 = __builtin_amdgcn_permlane32_swap(a1, b1, false, false); \
    u32x4 w = {r0[0], r1[0], r0[1], r1[1]}; OUT = *reinterpret_cast<bf16x8*>(&w); } while (0)
    PK4(p0, 0, pa0); PK4(p0, 8, pa1); PK4(p1, 0, pa2); PK4(p1, 8, pa3);
#undef PK4
}
__device__ __forceinline__ void qkt(f32x16& p0, f32x16& p1, const char* Ks, const bf16x8* qr, int r32, int hi) {
    p0 = f32x16{}; p1 = f32x16{};
    const char* kb = Ks + r32 * 32 + ((hi ^ ((r32 >> 3) & 1)) << 4);
    bf16x8 ka[4], kc[4];
    __builtin_amdgcn_s_setprio(1);
#pragma unroll
    for (int d0 = 0; d0 < 4; ++d0) { ka[d0] = *reinterpret_cast<const bf16x8*>(kb + d0 * 2048); kc[d0] = *reinterpret_cast<const bf16x8*>(kb + d0 * 2048 + 1024); }
    __builtin_amdgcn_sched_group_barrier(0x100, 8, 0);
#pragma unroll
    for (int d0 = 0; d0 < 12; ++d0) {
        p0 = __builtin_amdgcn_mfma_f32_32x32x16_bf16(ka[d0 & 3], qr[d0], p0, 0, 0, 0);
        p1 = __builtin_amdgcn_mfma_f32_32x32x16_bf16(kc[d0 & 3], qr[d0], p1, 0, 0, 0);
        __builtin_amdgcn_sched_group_barrier(0x8, 2, 0);
        if (d0 + 4 < 12) { ka[d0 & 3] = *reinterpret_cast<const bf16x8*>(kb + (d0 + 4) * 2048); kc[d0 & 3] = *reinterpret_cast<const bf16x8*>(kb + (d0 + 4) * 2048 + 1024);
            __builtin_amdgcn_sched_group_barrier(0x100, 2, 0); }
    }
    __builtin_amdgcn_s_setprio(0);
}
__device__ __forceinline__ int v_st(int k, int c) { const int kk = (k & ~0xC) | ((k & 4) << 1) | ((k & 8) >> 1); return ((kk >> 3) * 4 + (c >> 5)) * 512 + ((kk & 7) * 32 + (c & 31)) * 2; }
__device__ __forceinline__ int v_rd_base(int lane) { return ((lane & 3) << 3) | (((lane >> 2) & 3) << 6) | (((lane >> 4) & 1) << 5) | (((lane >> 5) & 1) << 8); }
constexpr int v_rd_off(int d0, int ks, int half) { return d0 * 512 + ks * 4096 + half * 2048; }
typedef short v4i16_t __attribute__((ext_vector_type(4)));
__device__ __forceinline__ bf16x8 vfrag(const LAS char* p) {
    const v4i16_t l = __builtin_amdgcn_ds_read_tr16_b64_v4i16((LAS v4i16_t*)p), h = __builtin_amdgcn_ds_read_tr16_b64_v4i16((LAS v4i16_t*)(p + 2048));
    return (bf16x8){l[0], l[1], l[2], l[3], h[0], h[1], h[2], h[3]};
}
__device__ __forceinline__ void pv_d0(f32x16* o, int vb, bf16x8 pa0, bf16x8 pa1, bf16x8 pa2, bf16x8 pa3) {
    const LAS char* p = (const LAS char*)(uintptr_t)(unsigned)vb;
    bf16x8 vf[3];
#pragma unroll
    for (int i = 0; i < 3; ++i) vf[i] = vfrag(p + i * 4096);
    __builtin_amdgcn_sched_group_barrier(0x100, 6, 0);
#pragma unroll
    for (int i = 0; i < 16; ++i) {
        const int d0 = i >> 2, ks = i & 3;
        o[d0] = __builtin_amdgcn_mfma_f32_32x32x16_bf16(ks == 0 ? pa0 : ks == 1 ? pa1 : ks == 2 ? pa2 : pa3, vf[i % 3], o[d0], 0, 0, 0);
        __builtin_amdgcn_sched_group_barrier(0x8, 1, 0);
        if (i + 3 < 16) { const int n = i + 3; vf[i % 3] = vfrag(p + (n >> 2) * 512 + (n & 3) * 4096); __builtin_amdgcn_sched_group_barrier(0x100, 2, 0); }
    }
}
template <int VAR>
__device__ __forceinline__ void attn_unit(const bf16_t* __restrict__ Qb, const bf16_t* __restrict__ Kh, const bf16_t* __restrict__ Vh, const bf16_t* Grow, bf16_t* Orow,
                                          int seq, char* lds) {
    const int tid = opaque_tid();
    const int wid = tid >> 6, lane = tid & 63, r32 = lane & 31, hi = lane >> 5;
    char* V_lds = lds + OFF_V; char* K_lds = lds + OFF_K;
    float* wsc = (float*)(lds + OFF_WS) + wid * 64; float* li_l = wsc; float* al_l = wsc + 32;
    float m_reg = -1e30f, l_reg = 0; f32x16 o[4] = {}; bf16x8 qr[12];
    const bf16_t* Qw = Qb + (unsigned)(wid * 32 + r32) * DQK + hi * 8;
#pragma unroll
    for (int d0 = 0; d0 < 12; ++d0) qr[d0] = *reinterpret_cast<const bf16x8*>(Qw + d0 * 16);
    const int sr = tid >> 4, sc = (tid & 15) * 8, vst0 = v_st(sr, sc), vst1 = v_st(32 + sr, sc);
    const int kr2 = tid >> 3, kc2 = 128 + (tid & 7) * 8;
    const int kst0 = KSWZ(sr, sc * 2), kst1 = KSWZ(32 + sr, sc * 2), kst2 = KSWZ(kr2, kc2 * 2);
    const int vb0 = (int)(uintptr_t)V_lds + v_rd_base(lane);
    bf16x8 vs0, vs1, ks0, ks1, ks2;
#define SLOAD(k0) do { vs0 = *(const bf16x8*)(Vh + (unsigned)((k0) + sr) * DV + sc); vs1 = *(const bf16x8*)(Vh + (unsigned)((k0) + 32 + sr) * DV + sc); \
    ks0 = *(const bf16x8*)(Kh + (unsigned)((k0) + sr) * DQK + sc); ks1 = *(const bf16x8*)(Kh + (unsigned)((k0) + 32 + sr) * DQK + sc); ks2 = *(const bf16x8*)(Kh + (unsigned)((k0) + kr2) * DQK + kc2); } while (0)
#define SWRITE(ko_, vo_) do { *(bf16x8*)(V_lds + (vo_) + vst0) = vs0; *(bf16x8*)(V_lds + (vo_) + vst1) = vs1; \
    *(bf16x8*)(K_lds + (ko_) + kst0) = ks0; *(bf16x8*)(K_lds + (ko_) + kst1) = ks1; *(bf16x8*)(K_lds + (ko_) + kst2) = ks2; } while (0)
#define SWAIT() asm volatile("s_waitcnt vmcnt(0)" ::: "memory")
#define RESC(a) do { if (__any((a) < 1.f)) { if (hi == 0) al_l[r32] = (a); asm volatile("s_waitcnt lgkmcnt(0)" ::: "memory"); \
    _Pragma("unroll") for (int d = 0; d < 4; ++d) _Pragma("unroll") for (int r = 0; r < 16; ++r) o[d][r] *= al_l[crow(r, hi)]; } } while (0)
    f32x16 p0, p1; float mn, al; bf16x8 pa0, pa1, pa2, pa3; const int NT = seq / 64;
    const bool lead = wid < 4;
    SLOAD(0); SWAIT(); SWRITE(0, 0); __syncthreads();
    SLOAD(64);
    int vo_prev = 0, vo_cur = 0, vo_next = SHM_V;
    for (int j = 0; j < NT; ++j) {
        const int ko = (j & 1) * SHM_K;
        if (!lead && j > 0) pv_d0(o, vb0 + vo_prev, pa0, pa1, pa2, pa3);
        qkt(p0, p1, K_lds + ko, qr, r32, hi);
        __builtin_amdgcn_s_setprio(2); partialSM(p0, p1, m_reg, mn, al); RESC(al);
        finishSM(p0, p1, al, l_reg, pa0, pa1, pa2, pa3); __builtin_amdgcn_s_setprio(0);
        if (j + 1 < NT) { SWAIT(); SWRITE(SHM_K - ko, vo_next); }
        if (j + 2 < NT) SLOAD((j + 2) * 64);
        if (lead) pv_d0(o, vb0 + vo_cur, pa0, pa1, pa2, pa3);
        __syncthreads();
        vo_prev = vo_cur; vo_cur = vo_next; vo_next = (vo_next == 2 * SHM_V) ? 0 : vo_next + SHM_V;
    }
    if (!lead) pv_d0(o, vb0 + vo_prev, pa0, pa1, pa2, pa3);
    if (hi == 0) li_l[r32] = l_reg;
    __syncthreads();
    const int te = opaque_tid(), wide = te >> 6, lanee = te & 63, r32e = te & 31, hie = (te >> 5) & 1;
    const float* lie = (const float*)(lds + OFF_WS) + wide * 64 + 4 * hie;
    unsigned short* ost = (unsigned short*)(lds + wide * 8192) + hie * 4 * 128 + r32e;
#pragma unroll
    for (int r = 0; r < 16; ++r) { const int oc = (r & 3) + 8 * (r >> 2); const float rl = __builtin_amdgcn_rcpf(lie[oc]);
#pragma unroll
        for (int d0 = 0; d0 < 4; ++d0) ost[oc * 128 + d0 * 32] = f2bf(o[d0][r] * rl); }
    asm volatile("s_waitcnt lgkmcnt(0)" ::: "memory");
#pragma unroll
    for (int i = 0; i < 8; ++i) { const int c = lanee + 64 * i, row = c >> 4, ch = c & 15;
        const u32x4 ov = *(const u32x4*)(lds + wide * 8192 + row * 256 + ch * 16);
        const unsigned goff = (unsigned)(wide * 32 + row) * 1024 + ch * 8;
        const u32x4 gv = *(const u32x4*)(Grow + goff);
        u32x4 w;
        w.x = cvt_pk_bf16(bf_lo(ov.x) * bf_lo(gv.x), bf_hi(ov.x) * bf_hi(gv.x)); w.y = cvt_pk_bf16(bf_lo(ov.y) * bf_lo(gv.y), bf_hi(ov.y) * bf_hi(gv.y));
        w.z = cvt_pk_bf16(bf_lo(ov.z) * bf_lo(gv.z), bf_hi(ov.z) * bf_hi(gv.z)); w.w = cvt_pk_bf16(bf_lo(ov.w) * bf_lo(gv.w), bf_hi(ov.w) * bf_hi(gv.w));
        *(u32x4*)(Orow + goff) = w; }
    __syncthreads();
#undef SLOAD
#undef SWRITE
#undef SWAIT
#undef RESC
}
}

template <int VAR>
__device__ __forceinline__ void phase_attn(const Ctx& X, char* lds, bool with_ctx) {
    const bf16_t* Qg = (const bf16_t*)(X.ws + WS_Q); const bf16_t* Kg = (const bf16_t*)(X.ws + WS_K); const bf16_t* Vg = (const bf16_t*)(X.ws + WS_V);
    const bf16_t* Gt = (const bf16_t*)(X.ws + WS_G); bf16_t* OG = (bf16_t*)(X.ws + (VAR ? WS_UR : WS_G));
    if (with_ctx) {
        for (int u = X.bid; u < NB * H; u += X.G) { const int b = u >> 3, h = u & 7, row0 = ML + b * TC;
            att::attn_unit<VAR>(Qg + ((size_t)h * M + row0) * DQK, Kg + (size_t)(b * H + h) * TK * DQK, Vg + (size_t)(b * H + h) * TK * DV,
                           Gt + (size_t)row0 * 1024 + h * 128, OG + (size_t)row0 * 1024 + h * 128, TC, lds); }
    }
    const int vcu = (X.G % 8 == 0) ? (X.bid % 8) * (X.G / 8) + X.bid / 8 : X.bid;
    for (int u = vcu; u < NB * H * (T / 256); u += X.G) { const int bh = u >> 5, b = bh >> 3, h = bh & 7, row0 = b * T + (u & 31) * 256;
        att::attn_unit<VAR>(Qg + ((size_t)h * M + row0) * DQK, Kg + (size_t)bh * TK * DQK, Vg + (size_t)bh * TK * DV,
                       Gt + (size_t)row0 * 1024 + h * 128, OG + (size_t)row0 * 1024 + h * 128, TK, lds); }
}


namespace fft {
typedef short v4i16_t __attribute__((ext_vector_type(4)));
using att::s16x4;
__device__ __forceinline__ bf16x8 bfrag(const LAS char* p) {
    const v4i16_t l = __builtin_amdgcn_ds_read_tr16_b64_v4i16((LAS v4i16_t*)p), h = __builtin_amdgcn_ds_read_tr16_b64_v4i16((LAS v4i16_t*)(p + 2048));
    return (bf16x8){l[0], l[1], l[2], l[3], h[0], h[1], h[2], h[3]};
}
}

__device__ __forceinline__ unsigned cvt_pk_vis(float lo, float hi) { return cvt_pk_bf16(lo, hi); }
__device__ __forceinline__ bf16x8 pack8(const f32x16& a, int base) {
    u32x4 w; w.x = cvt_pk_vis(a[base + 0], a[base + 1]); w.y = cvt_pk_vis(a[base + 2], a[base + 3]); w.z = cvt_pk_vis(a[base + 4], a[base + 5]); w.w = cvt_pk_vis(a[base + 6], a[base + 7]);
    return *reinterpret_cast<bf16x8*>(&w);
}
__device__ __forceinline__ void phase_fft1(const Ctx& X, LAS unsigned char* lds) {
    const int tid = opaque_tid(), wid = __builtin_amdgcn_readfirstlane(tid >> 6), lane = tid & 63, r32 = lane & 31, hi = lane >> 5;
    const int nb = wid & 3, mk = wid >> 2;
    const bf16_t* ZC = (const bf16_t*)(X.ws + WS_ZC);
    bf16_t* UR = (bf16_t*)(X.ws + WS_UR); bf16_t* UI = (bf16_t*)(X.ws + WS_UI);
    const bf16_t* A1 = (const bf16_t*)(X.ws + WS_A1); const float* TW = (const float*)(X.ws + WS_TW); const bf16_t* FT = (const bf16_t*)(X.ws + WS_FT);
    bf16x8 aR[8], aI[8];
#pragma unroll
    for (int k = 0; k < 8; ++k) { aR[k] = *(const bf16x8*)(A1 + (mk * 32 + r32) * 128 + k * 16 + hi * 8); aI[k] = *(const bf16x8*)(A1 + (64 + mk * 32 + r32) * 128 + k * 16 + hi * 8); }
    __syncthreads();
#pragma unroll
    for (int i = 0; i < 8; ++i) { const int idx = tid + 512 * i, n = idx >> 4, ch = idx & 15; *(LAS u32x4*)(lds + 16384 + n * 256 + ((ch ^ (n & 15)) << 4)) = *(const u32x4*)(FT + n * 128 + ch * 8); }
    const int zr0 = tid >> 4, zch = tid & 15;
    const int zst0 = zr0 * 256 + ((zch ^ (zr0 & 15)) << 4), zst1 = zst0 + 32 * 256;
    const LAS unsigned char* zrd = lds + r32 * 256;
    const LAS unsigned char* frd = lds + 16384 + (nb * 32 + r32) * 256;
    const int sw = r32 & 15;
    LAS unsigned short* OR_ = (LAS unsigned short*)(lds + 81920); LAS unsigned short* OI_ = (LAS unsigned short*)(lds + 98304);
    bf16x8 c0, c1;
#define F1_LOAD(it) do { const int b_ = (it) >> 10, t2_ = ((it) >> 3) & 127, g_ = (it) & 7; const unsigned o0 = (unsigned)(b_ * T + t2_ + 128 * zr0) * 1024 + g_ * 128 + zch * 8; \
        c0 = *(const bf16x8*)(ZC + o0); c1 = *(const bf16x8*)(ZC + o0 + 32 * 128 * 1024); } while (0)
    int it = X.bid;
    if (it < 4096) F1_LOAD(it);
    for (; it < 4096; it += X.G) {
        const int b = it >> 10, t2 = (it >> 3) & 127, g = it & 7;
        *(LAS bf16x8*)(lds + zst0) = c0; *(LAS bf16x8*)(lds + zst1) = c1;
        __syncthreads();
        if (it + X.G < 4096) F1_LOAD(it + X.G);
        f32x16 zc0 = {}, zc1 = {}, zs0 = {}, zs1 = {};
#pragma unroll
        for (int ks = 0; ks < 8; ++ks) { const int co = ((2 * ks + hi) ^ sw) << 4;
            const bf16x8 a0 = *(const LAS bf16x8*)(zrd + co), a1 = *(const LAS bf16x8*)(zrd + 8192 + co);
            const bf16x8 bc = *(const LAS bf16x8*)(frd + co), bs = *(const LAS bf16x8*)(frd + 32768 + co);
            zc0 = __builtin_amdgcn_mfma_f32_32x32x16_bf16(a0, bc, zc0, 0, 0, 0); zc1 = __builtin_amdgcn_mfma_f32_32x32x16_bf16(a1, bc, zc1, 0, 0, 0);
            zs0 = __builtin_amdgcn_mfma_f32_32x32x16_bf16(a0, bs, zs0, 0, 0, 0); zs1 = __builtin_amdgcn_mfma_f32_32x32x16_bf16(a1, bs, zs1, 0, 0, 0); }
        f32x16 accR = {}, accI = {};
#define F1_STEP(K8, SRC, BASE) do { const bf16x8 B = pack8(SRC, BASE); accR = __builtin_amdgcn_mfma_f32_32x32x16_bf16(aR[K8], B, accR, 0, 0, 0); accI = __builtin_amdgcn_mfma_f32_32x32x16_bf16(aI[K8], B, accI, 0, 0, 0); } while (0)
        F1_STEP(0, zc0, 0); F1_STEP(1, zc0, 8); F1_STEP(2, zc1, 0); F1_STEP(3, zc1, 8);
        F1_STEP(4, zs0, 0); F1_STEP(5, zs0, 8); F1_STEP(6, zs1, 0); F1_STEP(7, zs1, 8);
#undef F1_STEP
        const float* twp = TW + (t2 * 64 + mk * 32 + 4 * hi) * 2;
#pragma unroll
        for (int r = 0; r < 16; ++r) { const int oc = (r & 3) + 8 * (r >> 2); const float c = twp[oc * 2], sn = twp[oc * 2 + 1];
            const float ur = accR[r] * c + accI[r] * sn, ui = accI[r] * c - accR[r] * sn; const int k1 = mk * 32 + oc + 4 * hi;
            OR_[k1 * 128 + nb * 32 + r32] = f2bf(ur); OI_[k1 * 128 + nb * 32 + r32] = f2bf(ui); }
        __syncthreads();
#pragma unroll
        for (int i = 0; i < 2; ++i) { const int c = tid + 512 * i, k1 = c >> 4, ch = c & 15; const unsigned go = (unsigned)(b * T + k1 * 128 + t2) * 1024 + g * 128 + ch * 8;
            *(u32x4*)(UR + go) = *(const LAS u32x4*)(lds + 81920 + k1 * 256 + ch * 16); *(u32x4*)(UI + go) = *(const LAS u32x4*)(lds + 98304 + k1 * 256 + ch * 16); }
    }
#undef F1_LOAD
    __syncthreads();
}
__device__ __forceinline__ void phase_ctx_chan(const Ctx& X, LAS unsigned char* lds) {
    const int tid = opaque_tid();
    bf16_t* ZC = (bf16_t*)(X.ws + WS_ZC); bf16_t* ZS = (bf16_t*)(X.ws + WS_ZS);
    LAS float* zt = (LAS float*)lds; LAS float* cs = zt + 8 * 128; LAS float* sn = cs + 128;
    __syncthreads();
    if (tid < 128) { cs[tid] = cospif(tid * (1.f / 64.f)); sn[tid] = sinpif(tid * (1.f / 64.f)); }
    const int r = tid >> 6, kq = tid & 63;
    for (int it = X.bid; it < 1024; it += X.G) {
        const int rc = it >> 3, g = it & 7;
        __syncthreads();
        { const int idx = tid * 2, row = idx >> 7, c = idx & 127; const unsigned v = *(const unsigned*)(ZC + (unsigned)(ML + rc * 8 + row) * 1024 + g * 128 + c); zt[row * 128 + c] = bf_lo(v); zt[row * 128 + c + 1] = bf_hi(v); }
        __syncthreads();
        float ac0 = 0.f, as0 = 0.f, ac1 = 0.f, as1 = 0.f;
        for (int c = 0; c < 128; ++c) { const float z = zt[r * 128 + c]; const int i0 = (c * 2 * kq) & 127, i1 = (c * (2 * kq + 1)) & 127;
            ac0 += z * cs[i0]; as0 += z * sn[i0]; ac1 += z * cs[i1]; as1 += z * sn[i1]; }
        const unsigned o = (unsigned)(ML + rc * 8 + r) * 1024 + g * 128 + 2 * kq;
        *(unsigned*)(ZC + o) = cvt_pk_bf16(ac0, ac1); *(unsigned*)(ZS + o) = cvt_pk_bf16(as0, as1);
    }
    __syncthreads();
}

__device__ __forceinline__ void fft_store_out(const Ctx& X, LAS unsigned char* lds, int tid, unsigned rowbase, int rstride, int g) {
    const bf16_t* Gt = (const bf16_t*)(X.ws + WS_G); bf16_t* YG = (bf16_t*)(X.ws + WS_G);
#pragma unroll
    for (int i = 0; i < 4; ++i) { const int c = tid + 512 * i, m = c >> 4, ch = c & 15; const unsigned go = (rowbase + (unsigned)(rstride * m)) * 1024 + g * 128 + ch * 8;
        const u32x4 ov = *(const LAS u32x4*)(lds + 65536 + m * 256 + ch * 16); const u32x4 gv = *(const u32x4*)(Gt + go);
        u32x4 w;
        w.x = cvt_pk_bf16(bf_lo(ov.x) * bf_lo(gv.x), bf_hi(ov.x) * bf_hi(gv.x)); w.y = cvt_pk_bf16(bf_lo(ov.y) * bf_lo(gv.y), bf_hi(ov.y) * bf_hi(gv.y));
        w.z = cvt_pk_bf16(bf_lo(ov.z) * bf_lo(gv.z), bf_hi(ov.z) * bf_hi(gv.z)); w.w = cvt_pk_bf16(bf_lo(ov.w) * bf_lo(gv.w), bf_hi(ov.w) * bf_hi(gv.w));
        *(u32x4*)(YG + go) = w; }
}

__device__ __forceinline__ void phase_fft2(const Ctx& X, LAS unsigned char* lds) {
    const int tid = opaque_tid(), wid = __builtin_amdgcn_readfirstlane(tid >> 6), lane = tid & 63, r32 = lane & 31, hi = lane >> 5;
    const int mb = wid & 3, cp = wid >> 2;
    const bf16_t* UR = (const bf16_t*)(X.ws + WS_UR); const bf16_t* UI = (const bf16_t*)(X.ws + WS_UI);
    const bf16_t* A2 = (const bf16_t*)(X.ws + WS_A2);
    bf16x8 a2[16];
#pragma unroll
    for (int k = 0; k < 16; ++k) a2[k] = *(const bf16x8*)(A2 + (mb * 32 + r32) * 256 + k * 16 + hi * 8);
    const int sr = tid >> 4, sc = (tid & 15) * 8, vst0 = att::v_st(sr, sc), vst1 = att::v_st(32 + sr, sc);
    const LAS char* vb = (const LAS char*)lds + att::v_rd_base(lane) + cp * 1024;
    LAS unsigned short* OUT = (LAS unsigned short*)(lds + 65536);
    bf16x8 x0, x1, x2, x3, y0, y1, y2, y3;
#define F2_LOAD(it) do { const int b_ = (it) >> 9, k1_ = ((it) >> 3) & 63, g_ = (it) & 7; const unsigned o0 = (unsigned)(b_ * T + k1_ * 128 + sr) * 1024 + g_ * 128 + sc; \
        x0 = *(const bf16x8*)(UR + o0); x1 = *(const bf16x8*)(UR + o0 + 32 * 1024); x2 = *(const bf16x8*)(UR + o0 + 64 * 1024); x3 = *(const bf16x8*)(UR + o0 + 96 * 1024); \
        y0 = *(const bf16x8*)(UI + o0); y1 = *(const bf16x8*)(UI + o0 + 32 * 1024); y2 = *(const bf16x8*)(UI + o0 + 64 * 1024); y3 = *(const bf16x8*)(UI + o0 + 96 * 1024); } while (0)
    int it = X.bid;
    if (it < 2048) F2_LOAD(it);
    for (; it < 2048; it += X.G) {
        const int b = it >> 9, k1 = (it >> 3) & 63, g = it & 7;
        *(LAS bf16x8*)(lds + vst0) = x0; *(LAS bf16x8*)(lds + vst1) = x1; *(LAS bf16x8*)(lds + 16384 + vst0) = x2; *(LAS bf16x8*)(lds + 16384 + vst1) = x3;
        *(LAS bf16x8*)(lds + 32768 + vst0) = y0; *(LAS bf16x8*)(lds + 32768 + vst1) = y1; *(LAS bf16x8*)(lds + 49152 + vst0) = y2; *(LAS bf16x8*)(lds + 49152 + vst1) = y3;
        __syncthreads();
        if (it + X.G < 2048) F2_LOAD(it + X.G);
        f32x16 acc0 = {}, acc1 = {};
#pragma unroll
        for (int kt = 0; kt < 4; ++kt)
#pragma unroll
            for (int ks = 0; ks < 4; ++ks) { const bf16x8 B0 = fft::bfrag(vb + kt * 16384 + ks * 4096), B1 = fft::bfrag(vb + kt * 16384 + ks * 4096 + 512);
                acc0 = __builtin_amdgcn_mfma_f32_32x32x16_bf16(a2[kt * 4 + ks], B0, acc0, 0, 0, 0); acc1 = __builtin_amdgcn_mfma_f32_32x32x16_bf16(a2[kt * 4 + ks], B1, acc1, 0, 0, 0); }
#pragma unroll
        for (int r = 0; r < 16; ++r) { const int k2 = mb * 32 + (r & 3) + 8 * (r >> 2) + 4 * hi;
            OUT[k2 * 128 + cp * 64 + r32] = f2bf(acc0[r] * (1.f / 1024.f)); OUT[k2 * 128 + cp * 64 + 32 + r32] = f2bf(acc1[r] * (1.f / 1024.f)); }
        __syncthreads();
        fft_store_out(X, lds, tid, (unsigned)(b * T + k1), 64, g);
    }
#undef F2_LOAD
    __syncthreads();
}

__device__ __forceinline__ void phase_fft_ctx(const Ctx& X, LAS unsigned char* lds) {
    const int tid = opaque_tid(), wid = __builtin_amdgcn_readfirstlane(tid >> 6), lane = tid & 63, r32 = lane & 31, hi = lane >> 5;
    const int mb = wid & 3, cp = wid >> 2;
    const bf16_t* ZC = (const bf16_t*)(X.ws + WS_ZC); const bf16_t* ZS = (const bf16_t*)(X.ws + WS_ZS);
    const bf16_t* A3 = (const bf16_t*)(X.ws + WS_A3);
    const int sr = tid >> 4, sc = (tid & 15) * 8, vst0 = att::v_st(sr, sc), vst1 = att::v_st(32 + sr, sc);
    const LAS char* vb = (const LAS char*)lds + att::v_rd_base(lane) + cp * 1024;
    LAS unsigned short* OUT = (LAS unsigned short*)(lds + 65536);
    for (int it = X.bid; it < 64; it += X.G) {
        const int b = it >> 4, kb = (it >> 3) & 1, g = it & 7;
        f32x16 acc0 = {}, acc1 = {};
        for (int half = 0; half < 2; ++half) {
            const bf16_t* Z = half ? ZS : ZC;
            const unsigned o0 = (unsigned)(ML + b * TC + sr) * 1024 + g * 128 + sc;
            __syncthreads();
#pragma unroll
            for (int q = 0; q < 4; ++q) { *(LAS bf16x8*)(lds + q * 16384 + vst0) = *(const bf16x8*)(Z + o0 + (unsigned)(q * 64) * 1024); *(LAS bf16x8*)(lds + q * 16384 + vst1) = *(const bf16x8*)(Z + o0 + (unsigned)(q * 64 + 32) * 1024); }
            __syncthreads();
            const bf16_t* Ar = A3 + (kb * 128 + mb * 32 + r32) * 512 + half * 256 + hi * 8;
#pragma unroll
            for (int kt = 0; kt < 4; ++kt)
#pragma unroll
                for (int ks = 0; ks < 4; ++ks) { const bf16x8 Af = *(const bf16x8*)(Ar + kt * 64 + ks * 16);
                    const bf16x8 B0 = fft::bfrag(vb + kt * 16384 + ks * 4096), B1 = fft::bfrag(vb + kt * 16384 + ks * 4096 + 512);
                    acc0 = __builtin_amdgcn_mfma_f32_32x32x16_bf16(Af, B0, acc0, 0, 0, 0); acc1 = __builtin_amdgcn_mfma_f32_32x32x16_bf16(Af, B1, acc1, 0, 0, 0); }
        }
#pragma unroll
        for (int r = 0; r < 16; ++r) { const int k2 = mb * 32 + (r & 3) + 8 * (r >> 2) + 4 * hi;
            OUT[k2 * 128 + cp * 64 + r32] = f2bf(acc0[r] * 0.005524271728019903f); OUT[k2 * 128 + cp * 64 + 32 + r32] = f2bf(acc1[r] * 0.005524271728019903f); }
        __syncthreads();
        fft_store_out(X, lds, tid, (unsigned)(ML + b * TC + kb * 128), 1, g);
    }
    __syncthreads();
}

__device__ __forceinline__ void phase_dft_naive(const Ctx& X, LAS unsigned char* lds, bool with_ctx) {
    const int tid_ = opaque_tid(), lane_ = tid_ & 63, wave_ = __builtin_amdgcn_readfirstlane(tid_ >> 6); (void)lane_; (void)wave_;

    LAS float* ct = (LAS float*)lds; LAS float* st = ct + 8192;
    LAS unsigned* zcs = (LAS unsigned*)(st + 8192); LAS unsigned* zss = zcs + 64 * 32;
    const bf16_t* ZC = (const bf16_t*)(X.ws + WS_ZC); const bf16_t* ZS = (const bf16_t*)(X.ws + WS_ZS);
    const bf16_t* Gt = (const bf16_t*)(X.ws + WS_G); bf16_t* YG = (bf16_t*)(X.ws + WS_U);
    const int tid = tid_, tx = tid & 15, ty = tid >> 4;
    __syncthreads();
    for (int i = tid; i < 8192; i += 512) { const float x = (float)i * (1.f / 4096.f); ct[i] = cospif(x); st[i] = sinpif(x); }
    const int NI = 4096 + (with_ctx ? 128 : 0);
    for (int it = X.bid; it < NI; it += X.G) {
        int rowbase, k0, c0, Tn, mult; float scale;
        if (it < 4096) { const int b = it >> 10; k0 = ((it >> 4) & 63) * 128; c0 = (it & 15) * 64; rowbase = b * T; Tn = T; mult = 1; scale = 1.f / 1024.f; }
        else { const int ic = it - 4096, b = ic >> 5; k0 = ((ic >> 4) & 1) * 128; c0 = (ic & 15) * 64; rowbase = ML + b * TC; Tn = TC; mult = 32; scale = 0.005524271728019903f; }
        float acc[4][4];
#pragma unroll
        for (int i = 0; i < 4; ++i)
#pragma unroll
            for (int j = 0; j < 4; ++j) acc[i][j] = 0.f;
        const int kb = k0 + 4 * ty;
        for (int t0 = 0; t0 < Tn; t0 += 64) {
            __syncthreads();
            for (int i = 0; i < 4; ++i) { const int idx = tid + 512 * i, r = idx >> 5, c = idx & 31;
                zcs[idx] = ((const unsigned*)(ZC + (size_t)(rowbase + t0 + r) * 1024 + c0))[c];
                zss[idx] = ((const unsigned*)(ZS + (size_t)(rowbase + t0 + r) * 1024 + c0))[c]; }
            __syncthreads();
            for (int tt = 0; tt < 64; ++tt) {
                const int t = t0 + tt;
                const u32x2 zc2 = *(const LAS u32x2*)(zcs + tt * 32 + 2 * tx), zs2 = *(const LAS u32x2*)(zss + tt * 32 + 2 * tx);
                const float zc[4] = {bf_lo(zc2.x), bf_hi(zc2.x), bf_lo(zc2.y), bf_hi(zc2.y)}, zs[4] = {bf_lo(zs2.x), bf_hi(zs2.x), bf_lo(zs2.y), bf_hi(zs2.y)};
#pragma unroll
                for (int i = 0; i < 4; ++i) { const int ix = (((kb + i) * t) * mult) & 8191; const float c = ct[ix], s = st[ix];
#pragma unroll
                    for (int j = 0; j < 4; ++j) acc[i][j] += c * zc[j] - s * zs[j]; }
            }
        }
#pragma unroll
        for (int i = 0; i < 4; ++i) { const size_t off = (size_t)(rowbase + kb + i) * 1024 + c0 + 4 * tx;
            const u32x2 gg = *(const u32x2*)(Gt + off);
            u32x2 w; w.x = cvt_pk_bf16(acc[i][0] * scale * bf_lo(gg.x), acc[i][1] * scale * bf_hi(gg.x)); w.y = cvt_pk_bf16(acc[i][2] * scale * bf_lo(gg.y), acc[i][3] * scale * bf_hi(gg.y));
            *(u32x2*)(YG + off) = w; }
    }
    __syncthreads();
}

template <int LAYER>
__device__ __forceinline__ void run_layer(const Args& a, LAS unsigned char* lds, unsigned char* lds_g, const XcdBarrier& bar) {
    constexpr int P0 = 1 + 5 * LAYER, li = LAYER >> 1;
    constexpr int rows = (LAYER == 3) ? ML : M;
    constexpr int rows_out = (LAYER >= 2) ? ML : M;
#define PH_BEGIN(P) if (a.ph_lo <= (P) && (P) < a.ph_hi) { if ((P) > a.ph_lo) xcd_barrier(bar); const Ctx X(a); unsigned char* ws = X.ws; (void)ws; \
        const float* src_lat = (LAYER == 0) ? X.in[0] : X.out; const float* src_ctx = (LAYER == 0) ? X.in[2] : (const float*)(ws + WS_HC); (void)src_lat; (void)src_ctx; \
        float* HC = (float*)(ws + WS_HC); (void)HC; const float* mod = (const float*)(ws + WS_MOD) + LAYER * 5 * 3072; (void)mod;
#define PH_END }
    if constexpr (LAYER == 0) { PH_BEGIN(P0) phase_norm(X, LAYER, src_lat, src_ctx, rows); PH_END }
    if constexpr ((LAYER & 1) == 0) {
        PH_BEGIN(P0 + 1)
            unsigned char* wb = ws + WS_WMLA + li * WMLA_STRIDE;
            pg8::Gemm g{(const bf16_t*)(ws + WS_U), (const bf16_t*)(wb + WMLA_IN), M, 1536, 1024, 1024, 1024};
            pg8::StaticOrder S; S.init(M, 1536, X.G, X.bid);
            EpiMlaIn E{(bf16_t*)(ws + WS_CQKV), (float*)(ws + WS_SSQ), (bf16_t*)(ws + WS_G), (bf16_t*)(ws + WS_K), (const float*)(ws + WS_ROPE), (const float*)(ws + WS_SSQH), (const float*)(ws + WS_CV) + LAYER * 5 * 3072};
            pg8::gemm_phase(lds, g, S, E);
        PH_END
        PH_BEGIN(P0 + 2)
            unsigned char* wb = ws + WS_WMLA + li * WMLA_STRIDE;
            { pg8::Gemm g{(const bf16_t*)(ws + WS_CQKV), (const bf16_t*)(wb + WMLA_QUP), M, 1536, 256, 512, 256};
              pg8::StaticOrder S; S.init(M, 1536, X.G, X.bid);
              EpiQup E{(bf16_t*)(ws + WS_Q), (const float*)(ws + WS_SSQ), (const float*)(ws + WS_ROPE)};
              pg8::gemm_phase(lds, g, S, E); }
            { pg8::Gemm g{(const bf16_t*)(ws + WS_CQKV) + 256, (const bf16_t*)(wb + WMLA_KVUP), M, 2048, 128, 512, 128};
              pg8::StaticOrder S; S.init(M, 2048, X.G, X.bid);
              EpiKVup E{(bf16_t*)(ws + WS_K), (bf16_t*)(ws + WS_V), (const float*)(ws + WS_SSQ)};
              pg8::gemm_phase(lds, g, S, E); }
        PH_END
        PH_BEGIN(P0 + 3) phase_attn<0>(X, (char*)lds_g, LAYER == 0);
#ifdef PROBE_VAR
            if (LAYER == 0) { __syncthreads(); phase_attn<PROBE_VAR>(X, (char*)lds_g, false); }
#endif
        PH_END
        PH_BEGIN(P0 + 4)
            unsigned char* wb = ws + WS_WMLA + li * WMLA_STRIDE;
            pg8::Gemm g{(const bf16_t*)(ws + WS_G), (const bf16_t*)(wb + WMLA_OUT), rows_out, 1024, 1024, 1024, 1024};
            pg8::StaticOrder S; S.init(rows_out, 1024, X.G, X.bid);
            EpiOut E{src_lat, src_ctx, X.out, HC, mod, (LAYER < 3) ? (const float*)(ws + WS_GS) + (LAYER + 1) * 5 * 1024 : nullptr, (bf16_t*)(ws + WS_U), (float*)(ws + WS_SSQH)};
            pg8::gemm_phase(lds, g, S, E);
        PH_END
    } else {
        PH_BEGIN(P0 + 1)
            unsigned char* wb = ws + WS_WFNO + li * WFNO_STRIDE;
            pg8::Gemm g{(const bf16_t*)(ws + WS_U), (const bf16_t*)(wb + WFNO_IN), rows, 2048, 1024, 1024, 1024};
            pg8::StaticOrder S; S.init(rows, 2048, X.G, X.bid);
            EpiFnoIn E{(bf16_t*)(ws + WS_ZC), (bf16_t*)(ws + WS_ZS), (bf16_t*)(ws + WS_G), (const float*)(ws + WS_SSQH), (const float*)(ws + WS_CV) + LAYER * 5 * 3072};
            pg8::gemm_phase(lds, g, S, E);
        PH_END
        PH_BEGIN(P0 + 2) if (LAYER == 1) phase_ctx_chan(X, lds); phase_fft1(X, lds); PH_END
        PH_BEGIN(P0 + 3) if (LAYER == 1) phase_fft_ctx(X, lds); phase_fft2(X, lds); PH_END
        PH_BEGIN(P0 + 4)
            unsigned char* wb = ws + WS_WFNO + li * WFNO_STRIDE;
            pg8::Gemm g{(const bf16_t*)(ws + WS_G), (const bf16_t*)(wb + WFNO_OUT), rows_out, 1024, 1024, 1024, 1024};
            pg8::StaticOrder S; S.init(rows_out, 1024, X.G, X.bid);
            EpiOut E{src_lat, src_ctx, X.out, HC, mod, (LAYER < 3) ? (const float*)(ws + WS_GS) + (LAYER + 1) * 5 * 1024 : nullptr, (bf16_t*)(ws + WS_U), (float*)(ws + WS_SSQH)};
            pg8::gemm_phase(lds, g, S, E);
        PH_END
    }
}

__global__ void __launch_bounds__(512, 2) mk_fwd(Args a) {
    extern __shared__ __attribute__((aligned(16))) unsigned char lds_raw[];
    LAS unsigned char* lds = (LAS unsigned char*)lds_raw;
    constexpr int LAYER = 0;
    if (a.ph_hi > 100000) cg::this_grid().sync();
    XcdBarrier bar; bar.bar = (unsigned*)a.ws; bar.x = 0; bar.st = (volatile LAS unsigned*)(lds + 131072 + 1024);
    if (a.ph_hi - a.ph_lo > 1) {
        if (threadIdx.x < 16) ((volatile LAS unsigned*)(lds + 131072 + 1024))[threadIdx.x] = 0u;
        __syncthreads();
        bar = xcd_barrier_post((unsigned*)a.ws, (volatile LAS unsigned*)(lds + 131072 + 1024));
    }
    PH_BEGIN(0) phase_prologue(X, lds); PH_END
    run_layer<0>(a, lds, lds_raw, bar);
    run_layer<1>(a, lds, lds_raw, bar);
    run_layer<2>(a, lds, lds_raw, bar);
    run_layer<3>(a, lds, lds_raw, bar);
    PH_BEGIN(NPH - 1) phase_final(X); PH_END
}

extern "C" void kernel_launch(void* const* d_in, const int* in_sizes, int n_in, void* d_out, int out_size, void* d_ws, size_t ws_size, hipStream_t stream) {
    static int grid = 0;
    if (grid == 0) {
        if (n_in != 16 || out_size != ML * D || ws_size < WS_END) { fprintf(stderr, "kernel_launch: unexpected shapes n_in %d out %d ws %zu (need %zu)\n", n_in, out_size, ws_size, (size_t)WS_END); grid = -1; return; }
        int dev = 0, cus = 0, per_cu = 0;
        hipGetDevice(&dev); hipDeviceGetAttribute(&cus, hipDeviceAttributeMultiprocessorCount, dev);
        if (hipFuncSetAttribute((const void*)mk_fwd, hipFuncAttributeMaxDynamicSharedMemorySize, LDS_BYTES) != hipSuccess) { fprintf(stderr, "kernel_launch: hipFuncSetAttribute failed\n"); grid = -1; return; }
        hipOccupancyMaxActiveBlocksPerMultiprocessor(&per_cu, (const void*)mk_fwd, 512, LDS_BYTES);
        if (per_cu < 1) { fprintf(stderr, "kernel_launch: occupancy query says %d blocks per CU\n", per_cu); per_cu = 1; }
        (void)hipGetLastError();
        grid = cus;
    }
    if (grid < 0) return;
    if (hipMemsetAsync(d_ws, 0, 16384, stream) != hipSuccess) { fprintf(stderr, "kernel_launch: memset of the barrier words failed\n"); return; }
    Args a{};
    for (int i = 0; i < 16; ++i) a.in[i] = (const float*)d_in[i];
    a.out = (float*)d_out; a.ws = (unsigned char*)d_ws;
#if MK_SINGLE
    a.ph_lo = 0; a.ph_hi = NPH;
    void* args[] = {&a};
    hipError_t e = hipLaunchCooperativeKernel((const void*)mk_fwd, dim3(grid), dim3(512), args, LDS_BYTES, stream);
    if (e != hipSuccess) fprintf(stderr, "kernel_launch: cooperative launch failed: %s (grid %d)\n", hipGetErrorString(e), grid);
#else
    for (int ph = 0; ph < NPH; ++ph) {
        a.ph_lo = ph; a.ph_hi = ph + 1;
        hipLaunchKernelGGL(mk_fwd, dim3(grid), dim3(512), LDS_BYTES, stream, a);
    }
    const hipError_t le = hipPeekAtLastError();
    if (le != hipSuccess) fprintf(stderr, "kernel_launch: launch failed: %s\n", hipGetErrorName(le));
#endif
}
```

```cpp
#include <hip/hip_runtime.h>
#include <hip/hip_cooperative_groups.h>
#include <cstdio>
#include <cstdint>
namespace cg = cooperative_groups;

#ifndef MK_SINGLE
#define MK_SINGLE 1
#endif

#define LAS __attribute__((address_space(3)))
typedef unsigned short bf16_t;
typedef short bf16x8 __attribute__((ext_vector_type(8)));
typedef float f32x4 __attribute__((ext_vector_type(4)));
typedef float f32x16 __attribute__((ext_vector_type(16)));
typedef unsigned u32x4 __attribute__((ext_vector_type(4)));
typedef unsigned u32x2 __attribute__((ext_vector_type(2)));

constexpr int D = 1024, NB = 4, T = 8192, TC = 256, ML = NB * T, MC = NB * TC, M = ML + MC;
constexpr int H = 8, DQK = 192, DV = 128, TK = TC + T;
constexpr float EPS = 1e-6f;
constexpr float QSCALE = 0.07216878364870323f * 1.4426950408889634f;
constexpr int NPH = 22;

constexpr size_t MiB = 1u << 20;
constexpr size_t WS_MOD = 1 * MiB;
constexpr size_t WS_ROPE = 1 * MiB + 512 * 1024;
constexpr size_t WS_TW = 1 * MiB + 640 * 1024;
constexpr size_t WS_GS = 1 * MiB + 256 * 1024;
constexpr size_t WS_CV = 1 * MiB + 768 * 1024;
constexpr size_t WS_SSQH = 10 * MiB;
constexpr size_t WS_SSQ = 2 * MiB;
constexpr size_t WS_HC = 4 * MiB;
constexpr size_t WS_A1 = 8 * MiB;
constexpr size_t WS_A2 = 8 * MiB + 64 * 1024;
constexpr size_t WS_A3 = 8 * MiB + 256 * 1024;
constexpr size_t WS_FT = 9 * MiB;
constexpr size_t WS_WMLA = 16 * MiB;
constexpr size_t WMLA_IN = 0, WMLA_QUP = 3 * MiB, WMLA_KVUP = 4 * MiB, WMLA_OUT = 5 * MiB, WMLA_STRIDE = 8 * MiB;
constexpr size_t WS_WFNO = 32 * MiB;
constexpr size_t WFNO_IN = 0, WFNO_OUT = 6 * MiB, WFNO_STRIDE = 8 * MiB;
constexpr size_t WS_U = 64 * MiB;
constexpr size_t WS_G = 132 * MiB;
constexpr size_t WS_CQKV = 200 * MiB;
constexpr size_t WS_Q = 236 * MiB;
constexpr size_t WS_K = 336 * MiB;
constexpr size_t WS_V = 436 * MiB;
constexpr size_t WS_ZC = 236 * MiB, WS_ZS = 302 * MiB, WS_UR = 368 * MiB, WS_UI = 432 * MiB;
constexpr size_t WS_END = 504 * MiB;

constexpr int LDS_BYTES = 131072 + 2048;

typedef float f32x2_t __attribute__((ext_vector_type(2)));
typedef __bf16 bf16x2_t __attribute__((ext_vector_type(2)));
__device__ __forceinline__ unsigned cvt_pk_bf16(float lo, float hi) { const f32x2_t v = {lo, hi}; const bf16x2_t b = __builtin_convertvector(v, bf16x2_t); return __builtin_bit_cast(unsigned, b); }
__device__ __forceinline__ float bf_lo(unsigned u) { return __uint_as_float(u << 16); }
__device__ __forceinline__ float bf_hi(unsigned u) { return __uint_as_float(u & 0xffff0000u); }
__device__ __forceinline__ unsigned short f2bf(float f) { return (unsigned short)(cvt_pk_bf16(f, 0.f) & 0xffffu); }
__device__ __forceinline__ float silu_f(float x) { return x * __builtin_amdgcn_rcpf(1.f + __expf(-x)); }
__device__ __forceinline__ float shx(float v, int o, int lane) { return __int_as_float(__builtin_amdgcn_ds_bpermute((lane ^ o) << 2, __float_as_int(v))); }
__device__ __forceinline__ float wave_sum(float v, int lane) {
#pragma unroll
    for (int o = 1; o < 64; o <<= 1) v += shx(v, o, lane);
    return v;
}
#define LDS_WAIT() asm volatile("s_waitcnt lgkmcnt(0)" ::: "memory")
__device__ __forceinline__ f32x4 ld_nt4(const float* p) { return __builtin_nontemporal_load((const f32x4*)p); }
__device__ __forceinline__ void st_nt4(float* p, f32x4 v) { __builtin_nontemporal_store(v, (f32x4*)p); }
__device__ __forceinline__ float ld_nt1(const float* p) { return __builtin_nontemporal_load(p); }
__device__ __forceinline__ int opaque_tid() { int t; asm volatile("v_mov_b32 %0, %1" : "=v"(t) : "v"(threadIdx.x)); return t; }

struct Args { const float* in[16]; float* out; unsigned char* ws; int ph_lo, ph_hi; };
struct Ctx {
    const float* const* in; float* out; unsigned char* ws;
    int G, bid;
    __device__ __forceinline__ Ctx(const Args& a) { in = a.in; size_t z = 0; asm volatile("" : "+s"(z)); out = (float*)((unsigned char*)a.out + z); ws = a.ws + z; G = gridDim.x; bid = blockIdx.x; }
};


#define XB_TMO      128
#define XB_XCNT(j)  (256  + 64 * (j))
#define XB_XSUB(j)  (1280 + 64 * (j))
#define XB_XGEN(j)  (2304 + 64 * (j))
#define XB_TOP      3328
#define XB_TOPGEN   3392
#define XCD_BAR_WORDS 3456
#define XB_SPIN_CAP (1u << 22)
__device__ __forceinline__ unsigned xb_ld(unsigned* p)              { return __hip_atomic_load(p, __ATOMIC_RELAXED, __HIP_MEMORY_SCOPE_AGENT); }
__device__ __forceinline__ unsigned xb_add(unsigned* p, unsigned v) { return __hip_atomic_fetch_add(p, v, __ATOMIC_RELAXED, __HIP_MEMORY_SCOPE_AGENT); }
__device__ __forceinline__ unsigned xb_xcc_id() { return (unsigned)__builtin_amdgcn_s_getreg((3 << 11) | 20) & 0xFu; }
#define XB_SPIN(cond, bar) do { unsigned _sp = 0; while (cond) { __builtin_amdgcn_s_sleep(1); \
    if ((++_sp & 255u) == 0u) { if (xb_ld(&(bar)[XB_TMO])) break; if (_sp > XB_SPIN_CAP) { atomicAdd(&(bar)[XB_TMO], 1u); break; } } } } while (0)
struct XcdBarrier { unsigned* bar; unsigned x; volatile LAS unsigned* st; };
__device__ __forceinline__ XcdBarrier xcd_barrier_post(unsigned* bar, volatile LAS unsigned* st) {
    XcdBarrier b; b.bar = bar; b.x = xb_xcc_id(); b.st = st;
    if (threadIdx.x == 0) (void)xb_add(&bar[XB_XCNT(b.x)], 1u);
    return b;
}
__device__ __forceinline__ void xcd_barrier_complete(unsigned* bar, unsigned x, unsigned& nloc, unsigned& nx) {
    const unsigned G = gridDim.x * gridDim.y * gridDim.z;
    unsigned sum, cnt, mine, sp = 0u;
    for (;;) {
        sum = 0u; cnt = 0u; mine = 0u;
#pragma unroll
        for (unsigned j = 0; j < 16; ++j) { const unsigned c = xb_ld(&bar[XB_XCNT(j)]); sum += c; cnt += (c > 0u) ? 1u : 0u; mine = (j == x) ? c : mine; }
        if (sum == G) break;
        __builtin_amdgcn_s_sleep(1);
        if ((++sp & 255u) == 0u) { if (xb_ld(&bar[XB_TMO])) break; if (sp > XB_SPIN_CAP) { atomicAdd(&bar[XB_TMO], 1u); break; } }
    }
    nloc = mine > 0u ? mine : 1u; nx = cnt > 0u ? cnt : 1u;
}
__device__ __forceinline__ void xcd_barrier(const XcdBarrier& b) {
    asm volatile("s_waitcnt vmcnt(0)" ::: "memory");
    __syncthreads();
    if (threadIdx.x == 0) {
        unsigned* bar = b.bar;
        __builtin_amdgcn_s_waitcnt(0);
        unsigned nloc = b.st[0], nx = b.st[1];
        if (nloc == 0u) { xcd_barrier_complete(bar, b.x, nloc, nx); b.st[0] = nloc; b.st[1] = nx; }
        const unsigned old = xb_add(&bar[XB_XSUB(b.x)], 1u);
        const unsigned gen = old / nloc;
        if (old + 1u == (gen + 1u) * nloc) {
            __builtin_amdgcn_fence(__ATOMIC_RELEASE, "agent");
            asm volatile("s_waitcnt vmcnt(0)" ::: "memory");
            const unsigned og = xb_add(&bar[XB_TOP], 1u);
            const unsigned tg = og / nx;
            if (og + 1u == (tg + 1u) * nx) xb_add(&bar[XB_TOPGEN], 1u);
            else XB_SPIN(xb_ld(&bar[XB_TOPGEN]) == tg, bar);
            __builtin_amdgcn_fence(__ATOMIC_ACQUIRE, "agent");
            xb_add(&bar[XB_XGEN(b.x)], 1u);
            asm volatile("s_waitcnt vmcnt(0)" ::: "memory");
        } else {
            XB_SPIN(xb_ld(&bar[XB_XGEN(b.x)]) == gen, bar);
            __builtin_amdgcn_fence(__ATOMIC_ACQUIRE, "agent");
            asm volatile("s_waitcnt vmcnt(0)" ::: "memory");
        }
    }
    __syncthreads();
}

namespace pg8 {
constexpr int BM = 256, BK = 64, HALF = 128, HTB = HALF * BK * 2, NXCD = 8, WGM = 8;
__host__ __device__ __forceinline__ int lds_byte(int r, int c) { const int st = (r >> 4) * 2 + (c >> 5), rr = r & 15, cc = c & 31, ob = rr * 64 + cc * 2; return st * 1024 + (ob ^ (((ob >> 9) & 1) << 5)); }
__host__ __device__ __forceinline__ void stage_rc(int b, int& R, int& C) { const int st = b / 1024, sb = b % 1024, swz = sb ^ (((sb >> 9) & 1) << 5); R = (st >> 1) * 16 + swz / 64; C = (st & 1) * 32 + (swz % 64) / 2; }
__host__ __device__ __forceinline__ int perm32(int rho) { const int n = rho >> 4, i = rho & 15; return 8 * (i >> 2) + 4 * n + (i & 3); }
struct Unit { int pm, pn; };
struct Gemm { const bf16_t* A; const bf16_t* Bt; int M, N, K, lda, ldb; };
struct StaticOrder {
    int nM, nN, nwg, G, c;
    __device__ void init(int M_, int N_, int G_, int c_) { nM = M_ / BM; nN = N_ / BM; nwg = nM * nN; G = G_; c = c_; }
    __device__ bool next(int i, Unit& u) const {
        const long L = (long)i * G + c; if (L >= nwg) return false;
        int wgid = (int)L; { const int q = nwg / NXCD, r = nwg % NXCD, xcd = wgid % NXCD, off = wgid / NXCD; wgid = (xcd < r ? xcd * (q + 1) : r * (q + 1) + (xcd - r) * q) + off; }
        const int nig = WGM * nN, gid = wgid / nig, fm = gid * WGM, gsz = (nM - fm) < WGM ? (nM - fm) : WGM;
        u.pm = fm + ((wgid % nig) % gsz); u.pn = (wgid % nig) / gsz; return true;
    }
};

template <class Epi>
__device__ __forceinline__ void gemm_phase(LAS unsigned char* lds, const Gemm g, const StaticOrder& S, const Epi& E) {
    const int tid = opaque_tid(), wid = __builtin_amdgcn_readfirstlane(tid >> 6), lane = tid & 63, wr = wid >> 2, wc = wid & 3, fr = lane & 15, fq = lane >> 4;
    const int K = g.K, nt = K / BK;
    unsigned voffA[2], voffB[2];
#pragma unroll
    for (int i = 0; i < 2; ++i) { int R, C; stage_rc(tid * 16 + i * 8192, R, C); const int Rb = ((R & ~31) + perm32(R & 31));
        voffA[i] = (unsigned)(R * g.lda + C) * 2u; voffB[i] = (unsigned)(Rb * g.ldb + C) * 2u; }
    const size_t kstep = (size_t)(BK * 2);
    const size_t hstepA = (size_t)HALF * g.lda * 2, hstepB = (size_t)HALF * g.ldb * 2;
    const size_t tstepA = 2 * hstepA, tstepB = 2 * hstepB;
    const unsigned ldsw = (unsigned)wid * 1024u;
    const int aoff = lds_byte(wr * 64 + fr, fq * 8), boff = lds_byte(wc * 32 + fr, fq * 8);
#define PG8_SA(b, h) (((b) * 2 + (h)) * HTB)
#define PG8_SB(b, h) ((4 + (b) * 2 + (h)) * HTB)
#define PG8_STAGE(bufoff, gbase, voff) do { _Pragma("unroll") for (int _i = 0; _i < 2; ++_i) \
        __builtin_amdgcn_global_load_lds((const unsigned*)((const char*)(gbase) + (voff)[_i]), (LAS unsigned*)(lds + (bufoff) + ldsw + _i * 8192), 16, 0, 0); } while (0)
#define PG8_LDA(dst, b, h) do { _Pragma("unroll") for (int m = 0; m < 4; ++m) _Pragma("unroll") for (int k = 0; k < 2; ++k) dst[m][k] = *(const LAS bf16x8*)(lds + PG8_SA(b, h) + aoff + m * 2048 + k * 1024); } while (0)
#define PG8_LDB(dst, b, h) do { _Pragma("unroll") for (int n = 0; n < 2; ++n) _Pragma("unroll") for (int k = 0; k < 2; ++k) dst[n][k] = *(const LAS bf16x8*)(lds + PG8_SB(b, h) + boff + n * 2048 + k * 1024); } while (0)
#define PG8_MMA(ai, bj, At, Bt) do { __builtin_amdgcn_s_setprio(1); _Pragma("unroll") for (int m = 0; m < 4; ++m) _Pragma("unroll") for (int n = 0; n < 2; ++n) _Pragma("unroll") for (int k = 0; k < 2; ++k) \
        acc[ai][bj][m][n] = __builtin_amdgcn_mfma_f32_16x16x32_bf16(Bt[n][k], At[m][k], acc[ai][bj][m][n], 0, 0, 0); __builtin_amdgcn_s_setprio(0); } while (0)
#define PG8_WAIT_V(n) asm volatile("s_waitcnt vmcnt(" #n ")" ::: "memory")
#define PG8_WAIT_L(n) asm volatile("s_waitcnt lgkmcnt(" #n ")" ::: "memory")
#define PG8_BAR __builtin_amdgcn_s_barrier()
#define PG8_SCHED __builtin_amdgcn_sched_barrier(0)
    Unit cur, nxt; int ui = 0;
    if (!S.next(0, cur)) return;
    f32x4 acc[2][2][4][2];
#pragma unroll
    for (int a = 0; a < 2; ++a)
#pragma unroll
        for (int b = 0; b < 2; ++b)
#pragma unroll
            for (int m = 0; m < 4; ++m)
#pragma unroll
                for (int n = 0; n < 2; ++n) acc[a][b][m][n] = (f32x4){0.f, 0.f, 0.f, 0.f};
    bf16x8 At[4][2], B0[2][2], B1[2][2];
    const char* cA = (const char*)g.A + (size_t)cur.pm * tstepA; const char* cB = (const char*)g.Bt + (size_t)cur.pn * tstepB;
    PG8_STAGE(PG8_SB(0, 0), cB, voffB); PG8_STAGE(PG8_SB(0, 1), cB + hstepB, voffB); PG8_STAGE(PG8_SA(0, 0), cA, voffA); PG8_STAGE(PG8_SA(0, 1), cA + hstepA, voffA);
    if (wr == 1) PG8_BAR;
    PG8_WAIT_V(2); PG8_BAR;
    PG8_STAGE(PG8_SB(1, 0), cB + kstep, voffB); PG8_STAGE(PG8_SA(1, 0), cA + kstep, voffA); PG8_STAGE(PG8_SB(1, 1), cB + hstepB + kstep, voffB);
    PG8_WAIT_V(6); PG8_BAR;
    for (;;) {
        const bool has_next = S.next(ui + 1, nxt);
        const char* nA = has_next ? (const char*)g.A + (size_t)nxt.pm * tstepA : cA; const char* nB = has_next ? (const char*)g.Bt + (size_t)nxt.pn * tstepB : cB;
        for (int t = 0; t < nt; t += 2) {
            const bool last = (t == nt - 2);
            const char* a1 = cA + (size_t)(t + 1) * kstep;
            const char* a2 = last ? nA : cA + (size_t)(t + 2) * kstep; const char* b2 = last ? nB : cB + (size_t)(t + 2) * kstep;
            const char* a3 = a2 + kstep; const char* b3 = b2 + kstep;
            PG8_LDB(B0, 0, 0); PG8_LDB(B1, 0, 1); PG8_SCHED; PG8_LDA(At, 0, 0); PG8_STAGE(PG8_SA(1, 1), a1 + hstepA, voffA);
            PG8_WAIT_V(8); PG8_WAIT_L(0); PG8_BAR; PG8_MMA(0, 0, At, B0); PG8_MMA(0, 1, At, B1); PG8_BAR; PG8_SCHED;
            PG8_LDA(At, 0, 1); PG8_STAGE(PG8_SB(0, 0), b2, voffB); PG8_STAGE(PG8_SB(0, 1), b2 + hstepB, voffB); PG8_STAGE(PG8_SA(0, 0), a2, voffA);
            PG8_WAIT_V(8); PG8_WAIT_L(0); PG8_BAR; PG8_MMA(1, 0, At, B0); PG8_MMA(1, 1, At, B1); PG8_BAR; PG8_SCHED;
            PG8_LDB(B0, 1, 0); PG8_LDB(B1, 1, 1); PG8_SCHED; PG8_LDA(At, 1, 0); PG8_STAGE(PG8_SA(0, 1), a2 + hstepA, voffA);
            PG8_WAIT_V(8); PG8_WAIT_L(0); PG8_BAR; PG8_MMA(0, 0, At, B0); PG8_MMA(0, 1, At, B1); PG8_BAR; PG8_SCHED;
            PG8_LDA(At, 1, 1); PG8_STAGE(PG8_SB(1, 0), b3, voffB); PG8_STAGE(PG8_SB(1, 1), b3 + hstepB, voffB); PG8_STAGE(PG8_SA(1, 0), a3, voffA);
            PG8_WAIT_V(8); PG8_WAIT_L(0); PG8_BAR; PG8_MMA(1, 0, At, B0); PG8_MMA(1, 1, At, B1); PG8_BAR; PG8_SCHED;
        }
        if (wr == 0) PG8_BAR;
        { const int te = opaque_tid(); E(acc, cur, wr, wc, te & 15, (te >> 4) & 3); }
        if (!has_next) break;
#pragma unroll
        for (int a = 0; a < 2; ++a)
#pragma unroll
            for (int b = 0; b < 2; ++b)
#pragma unroll
                for (int m = 0; m < 4; ++m)
#pragma unroll
                    for (int n = 0; n < 2; ++n) acc[a][b][m][n] = (f32x4){0.f, 0.f, 0.f, 0.f};
        cur = nxt; cA = nA; cB = nB; ++ui;
        if (wr == 1) PG8_BAR;
    }
    PG8_WAIT_V(0);
    PG8_BAR;
#undef PG8_SA
#undef PG8_SB
#undef PG8_STAGE
#undef PG8_LDA
#undef PG8_LDB
#undef PG8_MMA
#undef PG8_WAIT_V
#undef PG8_WAIT_L
#undef PG8_BAR
#undef PG8_SCHED
}
}

typedef const f32x4 (&AccRef)[2][2][4][2];
__device__ __forceinline__ void store8(bf16_t* p, f32x4 v0, f32x4 v1) {
    u32x4 w; w.x = cvt_pk_bf16(v0[0], v0[1]); w.y = cvt_pk_bf16(v0[2], v0[3]); w.z = cvt_pk_bf16(v1[0], v1[1]); w.w = cvt_pk_bf16(v1[2], v1[3]);
    *(u32x4*)p = w;
}
__device__ __forceinline__ float sumsq8(f32x4 a, f32x4 b) { return (a[0] * a[0] + a[1] * a[1]) + (a[2] * a[2] + a[3] * a[3]) + (b[0] * b[0] + b[1] * b[1]) + (b[2] * b[2] + b[3] * b[3]); }
__device__ __forceinline__ void rope8(f32x4& v0, f32x4& v1, const float* cs) {
    const f32x4 c01 = *(const f32x4*)cs, c23 = *(const f32x4*)(cs + 4);
    f32x4 a, b;
    a[0] = v0[0] * c01[0] - v0[1] * c01[1]; a[1] = v0[1] * c01[0] + v0[0] * c01[1];
    a[2] = v0[2] * c01[2] - v0[3] * c01[3]; a[3] = v0[3] * c01[2] + v0[2] * c01[3];
    b[0] = v1[0] * c23[0] - v1[1] * c23[1]; b[1] = v1[1] * c23[0] + v1[0] * c23[1];
    b[2] = v1[2] * c23[2] - v1[3] * c23[3]; b[3] = v1[3] * c23[2] + v1[2] * c23[3];
    v0 = a; v1 = b;
}
__device__ __forceinline__ void row_key(int row, int& b, int& key) { if (row < ML) { b = row >> 13; key = TC + (row & (T - 1)); } else { const int mc = row - ML; b = mc >> 8; key = mc & (TC - 1); } }

__device__ __forceinline__ float row_rstd(const float* SSQH, int row) {
    const f32x4 a = *(const f32x4*)(SSQH + (unsigned)row * 16), b = *(const f32x4*)(SSQH + (unsigned)row * 16 + 4), c = *(const f32x4*)(SSQH + (unsigned)row * 16 + 8), d = *(const f32x4*)(SSQH + (unsigned)row * 16 + 12);
    const f32x4 t = (a + b) + (c + d);
    return __builtin_amdgcn_rsqf(((t[0] + t[1]) + (t[2] + t[3])) * (1.f / D) + EPS);
}
struct EpiMlaIn {
    bf16_t* CQKV; float* SSQ; bf16_t* Gt; bf16_t* Kb; const float* rope; const float* SSQH; const float* cv;
    __device__ __forceinline__ void operator()(AccRef acc, const pg8::Unit& u, int wr, int wc, int fr, int fq) const {
        const int row0 = u.pm * 256 + wr * 64 + fr;
        float rs8[8];
#pragma unroll
        for (int i = 0; i < 4; ++i) rs8[i] = row_rstd(SSQH, row0 + i * 16);
        int rowb = row0 + 128; asm volatile("" : "+v"(rowb) : "v"(rs8[0]), "v"(rs8[1]), "v"(rs8[2]), "v"(rs8[3]));
#pragma unroll
        for (int i = 4; i < 8; ++i) rs8[i] = row_rstd(SSQH, rowb + (i & 3) * 16);
        asm volatile("" :: "v"(rs8[4]), "v"(rs8[5]), "v"(rs8[6]), "v"(rs8[7]));
        const float* cvr = cv + ((u.pm * 256 < ML) ? (u.pm >> 5) : 4) * 3072 + u.pn * 256 + wc * 32 + 8 * fq;
        const f32x4 cv00 = *(const f32x4*)(cvr), cv01 = *(const f32x4*)(cvr + 4), cv10 = *(const f32x4*)(cvr + 128), cv11 = *(const f32x4*)(cvr + 132);
#pragma unroll
        for (int ai = 0; ai < 2; ++ai)
#pragma unroll
            for (int m = 0; m < 4; ++m) {
                __builtin_amdgcn_sched_barrier(0);
                const int row = row0 + ai * 128 + m * 16;
                const float rsn = rs8[ai * 4 + m];
                f32x4 av[2][2];
                av[0][0] = acc[ai][0][m][0] * rsn + cv00; av[0][1] = acc[ai][0][m][1] * rsn + cv01; av[1][0] = acc[ai][1][m][0] * rsn + cv10; av[1][1] = acc[ai][1][m][1] * rsn + cv11;
                if (u.pn == 0) {
                    float s = sumsq8(av[0][0], av[0][1]) + sumsq8(av[1][0], av[1][1]);
                    s += shx(s, 16, fr + 16 * fq); s += shx(s, 32, fr + 16 * fq);
                    if (fq == 0) SSQ[(unsigned)row * 8 + wc] = s;
                } else if (u.pn == 1) {
                    float s = sumsq8(av[0][0], av[0][1]);
                    s += shx(s, 16, fr + 16 * fq); s += shx(s, 32, fr + 16 * fq);
                    if (fq == 0) SSQ[(unsigned)row * 8 + 4 + wc] = s;
                }
#pragma unroll
                for (int bj = 0; bj < 2; ++bj) {
                    const int cbase = u.pn * 256 + bj * 128 + wc * 32, col8 = cbase + 8 * fq;
                    f32x4 v0 = av[bj][0], v1 = av[bj][1];
                    if (cbase < 384) { store8(CQKV + (unsigned)row * 512 + col8, v0, v1); }
                    else if (cbase < 448) {
                        store8(CQKV + (unsigned)row * 512 + col8, v0, v1);
                        const int half = (cbase - 384) >> 5;
                        if (row < ML) { const int t = row & (T - 1), pos = half ? (t & 63) : (t >> 6); rope8(v0, v1, rope + (pos * 16 + 4 * fq) * 2); }
                        int b, key; row_key(row, b, key);
                        u32x4 w; w.x = cvt_pk_bf16(v0[0], v0[1]); w.y = cvt_pk_bf16(v0[2], v0[3]); w.z = cvt_pk_bf16(v1[0], v1[1]); w.w = cvt_pk_bf16(v1[2], v1[3]);
                        bf16_t* kp = Kb + ((unsigned)(b * H) * TK + key) * DQK + 128 + half * 32 + 8 * fq;
#pragma unroll
                        for (int h = 0; h < H; ++h) *(u32x4*)(kp + (unsigned)h * TK * DQK) = w;
                    }
                    else if (cbase < 512) { unsigned z = 0u; asm volatile("" : "+v"(z)); *(u32x4*)(CQKV + (unsigned)row * 512 + col8) = (u32x4){z, z, z, z}; }
                    else {
                        f32x4 g0, g1;
#pragma unroll
                        for (int j = 0; j < 4; ++j) { g0[j] = silu_f(v0[j]); g1[j] = silu_f(v1[j]); }
                        store8(Gt + (unsigned)row * 1024 + (col8 - 512), g0, g1);
                    }
                }
            }
    }
};
struct EpiQup {
    bf16_t* Q; const float* SSQ; const float* rope;
    __device__ __forceinline__ void operator()(AccRef acc, const pg8::Unit& u, int wr, int wc, int fr, int fq) const {
        const int row0 = u.pm * 256 + wr * 64 + fr;
#pragma unroll
        for (int ai = 0; ai < 2; ++ai)
#pragma unroll
            for (int m = 0; m < 4; ++m) {
                __builtin_amdgcn_sched_barrier(0);
                const int row = row0 + ai * 128 + m * 16;
                const f32x4 sq = *(const f32x4*)(SSQ + (unsigned)row * 8);
                const float rs = QSCALE / sqrtf(((sq[0] + sq[1]) + (sq[2] + sq[3])) * (1.f / 256.f) + EPS);
#pragma unroll
                for (int bj = 0; bj < 2; ++bj) {
                    const int cbase = u.pn * 256 + bj * 128 + wc * 32;
                    f32x4 v0 = acc[ai][bj][m][0] * rs, v1 = acc[ai][bj][m][1] * rs;
                    int head, d;
                    if (cbase < 1024) { head = cbase >> 7; d = (cbase & 127) + 8 * fq; }
                    else { const int idx = (cbase - 1024) >> 5, half = idx & 1; head = idx >> 1; d = 128 + half * 32 + 8 * fq;
                        if (row < ML) { const int t = row & (T - 1), pos = half ? (t & 63) : (t >> 6); rope8(v0, v1, rope + (pos * 16 + 4 * fq) * 2); } }
                    store8(Q + ((unsigned)head * M + row) * DQK + d, v0, v1);
                }
            }
    }
};
struct EpiKVup {
    bf16_t* Kb; bf16_t* Vb; const float* SSQ;
    __device__ __forceinline__ void operator()(AccRef acc, const pg8::Unit& u, int wr, int wc, int fr, int fq) const {
        const int row0 = u.pm * 256 + wr * 64 + fr, head = u.pn;
#pragma unroll
        for (int ai = 0; ai < 2; ++ai)
#pragma unroll
            for (int m = 0; m < 4; ++m) {
                __builtin_amdgcn_sched_barrier(0);
                const int row = row0 + ai * 128 + m * 16;
                const f32x4 sq = *(const f32x4*)(SSQ + (unsigned)row * 8 + 4);
                const float rs = 1.f / sqrtf(((sq[0] + sq[1]) + (sq[2] + sq[3])) * (1.f / 128.f) + EPS);
                int b, key; row_key(row, b, key);
                const size_t kv = (unsigned)(b * H + head) * TK + key;
                store8(Kb + kv * DQK + wc * 32 + 8 * fq, acc[ai][0][m][0] * rs, acc[ai][0][m][1] * rs);
                store8(Vb + kv * DV + wc * 32 + 8 * fq, acc[ai][1][m][0] * rs, acc[ai][1][m][1] * rs);
            }
    }
};
struct EpiOut {
    const float* src_lat; const float* src_ctx; float* dst_lat; float* dst_ctx; const float* mod;
    const float* gs_next; bf16_t* Anext; float* SSQH;
    __device__ __forceinline__ void operator()(AccRef acc, const pg8::Unit& u, int wr, int wc, int fr, int fq) const {
        const int row0 = u.pm * 256 + wr * 64 + fr;
        const bool lat = u.pm * 256 < ML; const int r = lat ? (u.pm >> 5) : 4;
        const float* sb = lat ? src_lat + (unsigned)row0 * D : src_ctx + (unsigned)(row0 - ML) * D;
        float* db = lat ? dst_lat + (unsigned)row0 * D : dst_ctx + (unsigned)(row0 - ML) * D;
        const int c0 = u.pn * 256 + wc * 32 + 8 * fq;
        const float* gt = mod + r * 3072 + 2048 + c0;
        const f32x4 g00 = *(const f32x4*)(gt), g01 = *(const f32x4*)(gt + 4), g10 = *(const f32x4*)(gt + 128), g11 = *(const f32x4*)(gt + 132);
        f32x4 n00 = {1.f, 1.f, 1.f, 1.f}, n01 = n00, n10 = n00, n11 = n00;
        if (gs_next) { const float* gn = gs_next + r * 1024 + c0; n00 = *(const f32x4*)(gn); n01 = *(const f32x4*)(gn + 4); n10 = *(const f32x4*)(gn + 128); n11 = *(const f32x4*)(gn + 132); }
        f32x4 hc[4], hn[4];
        hc[0] = *(const f32x4*)(sb + c0); hc[1] = *(const f32x4*)(sb + c0 + 4); hc[2] = *(const f32x4*)(sb + c0 + 128); hc[3] = *(const f32x4*)(sb + c0 + 132);
#pragma unroll
        for (int i = 0; i < 8; ++i) {
            const int ai = i >> 2, m = i & 3, ro = (ai * 128 + m * 16) * D;
            if (i < 7) { const int rn = (((i + 1) >> 2) * 128 + ((i + 1) & 3) * 16) * D;
                hn[0] = *(const f32x4*)(sb + rn + c0); hn[1] = *(const f32x4*)(sb + rn + c0 + 4); hn[2] = *(const f32x4*)(sb + rn + c0 + 128); hn[3] = *(const f32x4*)(sb + rn + c0 + 132); }
            const f32x4 v00 = hc[0] + g00 * acc[ai][0][m][0], v01 = hc[1] + g01 * acc[ai][0][m][1], v10 = hc[2] + g10 * acc[ai][1][m][0], v11 = hc[3] + g11 * acc[ai][1][m][1];
            *(f32x4*)(db + ro + c0) = v00; *(f32x4*)(db + ro + c0 + 4) = v01; *(f32x4*)(db + ro + c0 + 128) = v10; *(f32x4*)(db + ro + c0 + 132) = v11;
            if (gs_next) {
                float ss = sumsq8(v00, v01) + sumsq8(v10, v11);
                const unsigned ao = (unsigned)(row0 + ai * 128 + m * 16) * 1024 + c0;
                store8(Anext + ao, v00 * n00, v01 * n01); store8(Anext + ao + 128, v10 * n10, v11 * n11);
                ss += shx(ss, 16, fr + 16 * fq); ss += shx(ss, 32, fr + 16 * fq);
                if (fq == 0) SSQH[(unsigned)(row0 + ai * 128 + m * 16) * 16 + u.pn * 4 + wc] = ss;
            }
#pragma unroll
            for (int q = 0; q < 4; ++q) hc[q] = hn[q];
        }
    }
};
struct EpiFnoIn {
    bf16_t* ZC; bf16_t* ZS; bf16_t* Gt; const float* SSQH; const float* cv;
    __device__ __forceinline__ void operator()(AccRef acc, const pg8::Unit& u, int wr, int wc, int fr, int fq) const {
        const int row0 = u.pm * 256 + wr * 64 + fr;
        float rs8[8];
#pragma unroll
        for (int i = 0; i < 4; ++i) rs8[i] = row_rstd(SSQH, row0 + i * 16);
        int rowb = row0 + 128; asm volatile("" : "+v"(rowb) : "v"(rs8[0]), "v"(rs8[1]), "v"(rs8[2]), "v"(rs8[3]));
#pragma unroll
        for (int i = 4; i < 8; ++i) rs8[i] = row_rstd(SSQH, rowb + (i & 3) * 16);
        asm volatile("" :: "v"(rs8[4]), "v"(rs8[5]), "v"(rs8[6]), "v"(rs8[7]));
        const float* cvr = cv + ((u.pm * 256 < ML) ? (u.pm >> 5) : 4) * 3072 + u.pn * 256 + wc * 32 + 8 * fq;
        const f32x4 cvq[2][2] = {{*(const f32x4*)(cvr), *(const f32x4*)(cvr + 4)}, {*(const f32x4*)(cvr + 128), *(const f32x4*)(cvr + 132)}};
#pragma unroll
        for (int ai = 0; ai < 2; ++ai)
#pragma unroll
            for (int m = 0; m < 4; ++m) {
                __builtin_amdgcn_sched_barrier(0);
                const int row = row0 + ai * 128 + m * 16;
                const float rsn = rs8[ai * 4 + m];
#pragma unroll
                for (int bj = 0; bj < 2; ++bj) {
                    const int col8 = u.pn * 256 + bj * 128 + wc * 32 + 8 * fq;
                    const f32x4 v0 = acc[ai][bj][m][0] * rsn + cvq[bj][0], v1 = acc[ai][bj][m][1] * rsn + cvq[bj][1];
                    if (u.pn < 4) store8(ZC + (unsigned)row * 1024 + col8, v0, v1);
                    else { f32x4 g0, g1;
#pragma unroll
                        for (int j = 0; j < 4; ++j) { g0[j] = silu_f(v0[j]); g1[j] = silu_f(v1[j]); }
                        store8(Gt + (unsigned)row * 1024 + (col8 - 1024), g0, g1); }
                }
            }
    }
};

__device__ __forceinline__ int rope_src(int j) { const int half = j >> 5, r = j & 31; return half * 32 + (r & 1) * 16 + (r >> 1); }
__device__ __forceinline__ int src_col(int kind, int n) {
    if (kind == 1) { if (n < 384) return n; if (n < 448) return 384 + rope_src(n - 384); if (n < 512) return -1; return n - 64; }
    if (kind == 2) { if (n < 1024) return (n >> 7) * 192 + (n & 127); const int mm = n - 1024; return (mm >> 6) * 192 + 128 + rope_src(mm & 63); }
    if (kind == 3) return 1024 + n;
    return n;
}
__device__ __forceinline__ void transpose_item(const float* W, int K, int Nsrc, bf16_t* WT, int Ndst, const float* gain, int kind, LAS float* scr, int item, int lane) {
    const int nblk = Ndst / 32, kb = item / nblk, nb = item % nblk, k0 = 64 * kb, n0 = 32 * nb;
    const int sc = src_col(kind, n0 + (lane & 31));
#pragma unroll
    for (int i = 0; i < 32; ++i) { const int kk = 2 * i + (lane >> 5);
        float v = (sc >= 0) ? ld_nt1(W + (size_t)(k0 + kk) * Nsrc + sc) : 0.f;
        if (gain) v *= gain[k0 + kk];
        scr[kk * 33 + (lane & 31)] = v; }
    LDS_WAIT(); asm volatile("" ::: "memory");
    const int c = lane & 7;
#pragma unroll
    for (int j = 0; j < 4; ++j) { const int n = (lane >> 3) + 8 * j; const LAS float* s = scr + (8 * c) * 33 + n;
        u32x4 o; o.x = cvt_pk_bf16(s[0 * 33], s[1 * 33]); o.y = cvt_pk_bf16(s[2 * 33], s[3 * 33]); o.z = cvt_pk_bf16(s[4 * 33], s[5 * 33]); o.w = cvt_pk_bf16(s[6 * 33], s[7 * 33]);
        *(u32x4*)(WT + (size_t)(n0 + n) * K + k0 + 8 * c) = o; }
    LDS_WAIT(); asm volatile("" ::: "memory");
}

__device__ __forceinline__ void phase_prologue(const Ctx& X, LAS unsigned char* lds) {
    const int tid_ = opaque_tid(), lane_ = tid_ & 63, wave_ = __builtin_amdgcn_readfirstlane(tid_ >> 6); (void)lane_; (void)wave_;

    unsigned char* ws = X.ws;
    {
        LAS float* scr = (LAS float*)(lds + wave_ * 8704);
        const int gw = X.bid * 8 + wave_, NGW = X.G * 8;
        constexpr int I_IN = 16 * 48, I_QUP = 4 * 48, I_KV = 2 * 64, I_OUT = 16 * 32, I_MLA = I_IN + I_QUP + I_KV + I_OUT, I_FIN = 16 * 64, I_FNO = I_FIN + I_OUT;
        constexpr int NIT = 2 * I_MLA + 2 * I_FNO;
        for (int it = gw; it < NIT; it += NGW) {
            int r = it;
            if (r < 2 * I_MLA) {
                const int l = r / I_MLA; r -= l * I_MLA;
                unsigned char* wb = ws + WS_WMLA + l * WMLA_STRIDE;
                if (r < I_IN) { transpose_item(X.in[7] + (size_t)l * 1024 * 1472, 1024, 1472, (bf16_t*)(wb + WMLA_IN), 1536, nullptr, 1, scr, r, lane_); continue; } r -= I_IN;
                if (r < I_QUP) { transpose_item(X.in[9] + (size_t)l * 256 * 1536, 256, 1536, (bf16_t*)(wb + WMLA_QUP), 1536, X.in[8] + l * 256, 2, scr, r, lane_); continue; } r -= I_QUP;
                if (r < I_KV) { transpose_item(X.in[11] + (size_t)l * 128 * 2048, 128, 2048, (bf16_t*)(wb + WMLA_KVUP), 2048, X.in[10] + l * 128, 0, scr, r, lane_); continue; } r -= I_KV;
                transpose_item(X.in[12] + (size_t)l * 1024 * 1024, 1024, 1024, (bf16_t*)(wb + WMLA_OUT), 1024, nullptr, 0, scr, r, lane_);
            } else {
                r -= 2 * I_MLA; const int l = r / I_FNO; r -= l * I_FNO;
                unsigned char* wb = ws + WS_WFNO + l * WFNO_STRIDE;
                if (r < I_FIN) { transpose_item(X.in[13] + (size_t)l * 1024 * 2048, 1024, 2048, (bf16_t*)(wb + WFNO_IN), 2048, nullptr, 0, scr, r, lane_); continue; } r -= I_FIN;
                transpose_item(X.in[14] + (size_t)l * 1024 * 1024, 1024, 1024, (bf16_t*)(wb + WFNO_OUT), 1024, nullptr, 0, scr, r, lane_);
            }
        }
    }
    __syncthreads();
    constexpr int NB_ZF = 0, NB_MOD = 4 * 48;
    constexpr int TAB_ROPE = 2048, TAB_TW = 8192, TAB_A1 = 16384, TAB_A2 = 32768, TAB_A3 = 131072, TAB_FT = 32768, TAB_ALL = TAB_ROPE + TAB_TW + TAB_A1 + TAB_A2 + TAB_A3 + TAB_FT;
    constexpr int NB_TAB = (TAB_ALL + 4095) / 4096;
    for (int it = X.bid; it < NB_ZF + NB_MOD + NB_TAB; it += X.G) {
        if (it < NB_ZF) {
            const int l = it >> 8, kb = (it >> 3) & 31, g = it & 7, k0 = kb * 32;
            LAS float* Wt = (LAS float*)lds; LAS float* cs = Wt + 32 * 129; LAS float* sn = cs + 128;
            const float* W = X.in[13] + (size_t)l * 1024 * 2048;
            for (int i = 0; i < 8; ++i) { const int idx = tid_ + 512 * i, kk = idx >> 7, c = idx & 127; Wt[kk * 129 + c] = W[(size_t)(k0 + kk) * 2048 + g * 128 + c]; }
            if (tid_ < 128) { cs[tid_] = cospif(tid_ * (1.f / 64.f)); sn[tid_] = sinpif(tid_ * (1.f / 64.f)); }
            __syncthreads();
            bf16_t* WT = (bf16_t*)(ws + WS_WFNO + l * WFNO_STRIDE + WFNO_IN);
            const int kk = tid_ & 31, k2b = tid_ >> 5;
            for (int j = 0; j < 8; ++j) { const int k2 = k2b + 16 * j; float ac = 0.f, as = 0.f;
                for (int c = 0; c < 128; ++c) { const float w = Wt[kk * 129 + c]; const int ix = (c * k2) & 127; ac += w * cs[ix]; as += w * sn[ix]; }
                WT[(size_t)(g * 128 + k2) * 1024 + k0 + kk] = f2bf(ac); WT[(size_t)(1024 + g * 128 + k2) * 1024 + k0 + kk] = f2bf(as); }
            __syncthreads();
        } else if (it < NB_ZF + NB_MOD) {
            const int r0 = it - NB_ZF, l = r0 / 48, chunk = r0 % 48;
            LAS float* act = (LAS float*)lds; LAS float* red = act + 5 * 1024;
            for (int i = tid_; i < 5 * 1024; i += 512) { const float v = (i < 4096) ? X.in[1][i] : X.in[3][i - 4096]; act[i] = silu_f(v); }
            __syncthreads();
            const int cq4 = tid_ & 15, kg = tid_ >> 4;
            const float* w = X.in[5] + (size_t)l * 1024 * 3072 + chunk * 64 + cq4 * 4;
            f32x4 a0 = {0.f, 0.f, 0.f, 0.f}, a1 = a0, a2 = a0, a3 = a0, a4 = a0;
#pragma unroll 1
            for (int hf = 0; hf < 2; ++hf) {
                f32x4 wv[16];
#pragma unroll
                for (int k = 0; k < 16; ++k) wv[k] = ld_nt4(w + (size_t)(kg * 32 + hf * 16 + k) * 3072);
#pragma unroll
                for (int k = 0; k < 16; ++k) { const int kk = kg * 32 + hf * 16 + k;
                    a0 += wv[k] * act[kk]; a1 += wv[k] * act[1024 + kk]; a2 += wv[k] * act[2048 + kk]; a3 += wv[k] * act[3072 + kk]; a4 += wv[k] * act[4096 + kk]; }
            }
            *(LAS f32x4*)(red + (kg * 5 + 0) * 64 + cq4 * 4) = a0; *(LAS f32x4*)(red + (kg * 5 + 1) * 64 + cq4 * 4) = a1; *(LAS f32x4*)(red + (kg * 5 + 2) * 64 + cq4 * 4) = a2;
            *(LAS f32x4*)(red + (kg * 5 + 3) * 64 + cq4 * 4) = a3; *(LAS f32x4*)(red + (kg * 5 + 4) * 64 + cq4 * 4) = a4;
            __syncthreads();
            if (tid_ < 320) { const int r = tid_ >> 6, c2 = tid_ & 63; float s = X.in[6][l * 3072 + chunk * 64 + c2];
                for (int q = 0; q < 32; ++q) s += red[(q * 5 + r) * 64 + c2];
                ((float*)(ws + WS_MOD))[(l * 5 + r) * 3072 + chunk * 64 + c2] = s;
                if (chunk >= 16 && chunk < 32) { const int cc = (chunk - 16) * 64 + c2; ((float*)(ws + WS_GS))[(l * 5 + r) * 1024 + cc] = X.in[4][l * 1024 + cc] * (1.f + s); } }
            __syncthreads();
        } else {
            const int base = (it - NB_ZF - NB_MOD) * 4096;
            for (int i = 0; i < 8; ++i) {
                int idx = base + tid_ + 512 * i; if (idx >= TAB_ALL) break;
                if (idx < TAB_ROPE) { const int pos = idx >> 4, j = idx & 15; const float inv = 1.0f / powf(10000.0f, (float)(2 * j) / 32.0f); const float ang = (float)pos * inv;
                    ((float*)(ws + WS_ROPE))[idx * 2] = cosf(ang); ((float*)(ws + WS_ROPE))[idx * 2 + 1] = sinf(ang); continue; }
                idx -= TAB_ROPE;
                if (idx < TAB_TW) { const int t2 = idx >> 6, k1 = idx & 63; const float x = (float)(t2 * k1) * (1.f / 4096.f);
                    ((float*)(ws + WS_TW))[idx * 2] = cospif(x); ((float*)(ws + WS_TW))[idx * 2 + 1] = sinpif(x); continue; }
                idx -= TAB_TW;
                if (idx < TAB_A1) { const int row = idx >> 7, k = idx & 127, k1 = row & 63, e = k & 63;
                    const int t1 = 32 * (e >> 5) + 16 * ((e >> 4) & 1) + 8 * ((e & 7) >> 2) + 4 * ((e >> 3) & 1) + (e & 3); const float x = (float)((k1 * t1) & 63) * (1.f / 32.f);
                    const float c = cospif(x), s = sinpif(x); float v;
                    if (row < 64) v = (k < 64) ? c : -s; else v = (k < 64) ? -s : -c;
                    ((bf16_t*)(ws + WS_A1))[idx] = f2bf(v); continue; }
                idx -= TAB_A1;
                if (idx < TAB_A2) { const int k2 = idx >> 8, k = idx & 255, t2 = k & 127; const float x = (float)((k2 * t2) & 127) * (1.f / 64.f);
                    ((bf16_t*)(ws + WS_A2))[idx] = f2bf(k < 128 ? cospif(x) : sinpif(x)); continue; }
                idx -= TAB_A2;
                if (idx < TAB_A3) { const int kk = idx >> 9, k = idx & 511, t = k & 255; const float x = (float)((kk * t) & 255) * (1.f / 128.f);
                    ((bf16_t*)(ws + WS_A3))[idx] = f2bf(k < 256 ? cospif(x) : -sinpif(x)); continue; }
                idx -= TAB_A3;
                { const int n = idx >> 7, c = idx & 127, k2 = n & 127; const float x = (float)((c * k2) & 127) * (1.f / 64.f);
                    ((bf16_t*)(ws + WS_FT))[idx] = f2bf(n < 128 ? cospif(x) : sinpif(x)); }
            }
        }
    }
}

__device__ __forceinline__ void phase_norm(const Ctx& X, int layer, const float* src_lat, const float* src_ctx, int rows) {
    const int tid_ = opaque_tid(), lane_ = tid_ & 63, wave_ = __builtin_amdgcn_readfirstlane(tid_ >> 6);
    const float* gs = (const float*)(X.ws + WS_GS) + layer * 5 * 1024;
    bf16_t* U = (bf16_t*)(X.ws + WS_U); float* SSQH = (float*)(X.ws + WS_SSQH);
    const int gw = X.bid * 8 + wave_, NGW = X.G * 8;
    for (int it = gw; it < 2 * 1536 + 2 * 2048; it += NGW) {
        int l, n, N; const bf16_t* Wt;
        if (it < 3072) { const int li = it / 1536; n = it % 1536; l = 2 * li; N = 1536; Wt = (const bf16_t*)(X.ws + WS_WMLA + li * WMLA_STRIDE + WMLA_IN); }
        else { const int q = it - 3072, li = q / 2048; n = q % 2048; l = 2 * li + 1; N = 2048; Wt = (const bf16_t*)(X.ws + WS_WFNO + li * WFNO_STRIDE + WFNO_IN); }
        (void)N;
        const u32x4 w0 = *(const u32x4*)(Wt + (size_t)n * 1024 + lane_ * 16), w1 = *(const u32x4*)(Wt + (size_t)n * 1024 + lane_ * 16 + 8);
        const float wf[16] = {bf_lo(w0.x), bf_hi(w0.x), bf_lo(w0.y), bf_hi(w0.y), bf_lo(w0.z), bf_hi(w0.z), bf_lo(w0.w), bf_hi(w0.w),
                              bf_lo(w1.x), bf_hi(w1.x), bf_lo(w1.y), bf_hi(w1.y), bf_lo(w1.z), bf_hi(w1.z), bf_lo(w1.w), bf_hi(w1.w)};
        const float* sh = (const float*)(X.ws + WS_MOD) + l * 5 * 3072 + lane_ * 16;
#pragma unroll
        for (int r = 0; r < 5; ++r) { float acc = 0.f;
#pragma unroll
            for (int k = 0; k < 16; ++k) acc += sh[r * 3072 + k] * wf[k];
            acc = wave_sum(acc, lane_);
            if (lane_ == 0) ((float*)(X.ws + WS_CV))[(l * 5 + r) * 3072 + n] = acc; }
    }
    f32x4 nx[4];
    if (gw < rows) { const float* row = (gw < ML) ? src_lat + (size_t)gw * D : src_ctx + (size_t)(gw - ML) * D;
#pragma unroll
        for (int j = 0; j < 4; ++j) nx[j] = ld_nt4(row + 4 * lane_ + 256 * j); }
    for (int m = gw; m < rows; m += NGW) {
        const float* gr = gs + ((m < ML) ? (m >> 13) : 4) * 1024;
        f32x4 cu[4];
#pragma unroll
        for (int j = 0; j < 4; ++j) cu[j] = nx[j];
        if (m + NGW < rows) { const int m2 = m + NGW; const float* row2 = (m2 < ML) ? src_lat + (size_t)m2 * D : src_ctx + (size_t)(m2 - ML) * D;
#pragma unroll
            for (int j = 0; j < 4; ++j) nx[j] = ld_nt4(row2 + 4 * lane_ + 256 * j); }
        float s = 0.f;
#pragma unroll
        for (int j = 0; j < 4; ++j) { const int c = 4 * lane_ + 256 * j; const f32x4 v = cu[j]; s += (v[0] * v[0] + v[1] * v[1]) + (v[2] * v[2] + v[3] * v[3]);
            const f32x4 o = v * *(const f32x4*)(gr + c);
            u32x2 w; w.x = cvt_pk_bf16(o[0], o[1]); w.y = cvt_pk_bf16(o[2], o[3]);
            *(u32x2*)(U + (size_t)m * D + c) = w; }
        s = wave_sum(s, lane_);
        if (lane_ < 16) SSQH[(size_t)m * 16 + lane_] = (lane_ == 0) ? s : 0.f;
    }
}
__device__ __forceinline__ void phase_final(const Ctx& X) {
    const int tid_ = opaque_tid(), lane_ = tid_ & 63, wave_ = __builtin_amdgcn_readfirstlane(tid_ >> 6); (void)lane_; (void)wave_;

    const float* g = X.in[15];
    const int gw = X.bid * 8 + wave_, NGW = X.G * 8;
    f32x4 nx[4];
    if (gw < ML) {
#pragma unroll
        for (int j = 0; j < 4; ++j) nx[j] = ld_nt4(X.out + (size_t)gw * D + 4 * lane_ + 256 * j); }
    for (int m = gw; m < ML; m += NGW) {
        float* row = X.out + (size_t)m * D;
        f32x4 v[4]; float s = 0.f;
#pragma unroll
        for (int j = 0; j < 4; ++j) v[j] = nx[j];
        if (m + NGW < ML) {
#pragma unroll
            for (int j = 0; j < 4; ++j) nx[j] = ld_nt4(X.out + (size_t)(m + NGW) * D + 4 * lane_ + 256 * j); }
#pragma unroll
        for (int j = 0; j < 4; ++j) s += (v[j][0] * v[j][0] + v[j][1] * v[j][1]) + (v[j][2] * v[j][2] + v[j][3] * v[j][3]);
        const float rstd = 1.f / sqrtf(wave_sum(s, lane_) * (1.f / D) + EPS);
#pragma unroll
        for (int j = 0; j < 4; ++j) { const int c = 4 * lane_ + 256 * j; const f32x4 gg = *(const f32x4*)(g + c); st_nt4(row + c, v[j] * rstd * gg); }
    }
}

__device__ __forceinline__ void phase_attn_naive(const Ctx& X, LAS unsigned char* lds, bool with_ctx) {
    const int tid_ = opaque_tid(), lane_ = tid_ & 63, wave_ = __builtin_amdgcn_readfirstlane(tid_ >> 6); (void)lane_; (void)wave_;

    LAS unsigned* Qs = (LAS unsigned*)lds;
    LAS unsigned* Ks = Qs + 128 * 97;
    LAS unsigned* Vs = Ks + 64 * 97;
    LAS float* Ps = (LAS float*)(Vs + 64 * 64);
    const bf16_t* Qg = (const bf16_t*)(X.ws + WS_Q); const bf16_t* Kg = (const bf16_t*)(X.ws + WS_K); const bf16_t* Vg = (const bf16_t*)(X.ws + WS_V);
    const bf16_t* Gt = (const bf16_t*)(X.ws + WS_G); bf16_t* OG = (bf16_t*)(X.ws + WS_U);
    const int tid = tid_, tx = tid & 15, ty = tid >> 4;
    const int NU = 2048 + (with_ctx ? 64 : 0);
    for (int unit = X.bid; unit < NU; unit += X.G) {
        int b, h, row0, nkeys;
        if (unit < 2048) { b = unit >> 9; h = (unit >> 6) & 7; row0 = b * T + (unit & 63) * 128; nkeys = TK; }
        else { const int uc = unit - 2048; b = uc >> 4; h = (uc >> 1) & 7; row0 = ML + b * TC + (uc & 1) * 128; nkeys = TC; }
        const unsigned* Qp = (const unsigned*)(Qg + ((size_t)h * M + row0) * DQK);
        const unsigned* Kp = (const unsigned*)(Kg + (size_t)(b * H + h) * TK * DQK);
        const unsigned* Vp = (const unsigned*)(Vg + (size_t)(b * H + h) * TK * DV);
        __syncthreads();
        for (int i = 0; i < 24; ++i) { const int idx = tid + 512 * i, r = idx / 96, c = idx % 96; Qs[r * 97 + c] = Qp[(size_t)r * 96 + c]; }
        float mi[4], li[4], o[4][8];
#pragma unroll
        for (int i = 0; i < 4; ++i) { mi[i] = -1e30f; li[i] = 0.f;
#pragma unroll
            for (int c = 0; c < 8; ++c) o[i][c] = 0.f; }
        for (int kt = 0; kt < nkeys; kt += 64) {
            __syncthreads();
            for (int i = 0; i < 12; ++i) { const int idx = tid + 512 * i, r = idx / 96, c = idx % 96; Ks[r * 97 + c] = Kp[(size_t)(kt + r) * 96 + c]; }
            for (int i = 0; i < 8; ++i) { const int idx = tid + 512 * i; Vs[idx] = Vp[(size_t)kt * 64 + idx]; }
            __syncthreads();
            float s[4][4];
#pragma unroll
            for (int i = 0; i < 4; ++i)
#pragma unroll
                for (int j = 0; j < 4; ++j) s[i][j] = 0.f;
            for (int c = 0; c < 96; ++c) {
                unsigned q[4], k[4];
#pragma unroll
                for (int i = 0; i < 4; ++i) { q[i] = Qs[(4 * ty + i) * 97 + c]; k[i] = Ks[(4 * tx + i) * 97 + c]; }
#pragma unroll
                for (int i = 0; i < 4; ++i)
#pragma unroll
                    for (int j = 0; j < 4; ++j) s[i][j] += bf_lo(q[i]) * bf_lo(k[j]) + bf_hi(q[i]) * bf_hi(k[j]);
            }
#pragma unroll
            for (int i = 0; i < 4; ++i) {
                float mx = fmaxf(fmaxf(s[i][0], s[i][1]), fmaxf(s[i][2], s[i][3]));
                mx = fmaxf(mx, shx(mx, 1, lane_)); mx = fmaxf(mx, shx(mx, 2, lane_)); mx = fmaxf(mx, shx(mx, 4, lane_)); mx = fmaxf(mx, shx(mx, 8, lane_));
                const float mn = fmaxf(mi[i], mx), alpha = exp2f(mi[i] - mn);
                float rs = 0.f;
#pragma unroll
                for (int j = 0; j < 4; ++j) { const float p = exp2f(s[i][j] - mn); rs += p; Ps[(4 * ty + i) * 65 + 4 * tx + j] = p; }
                rs += shx(rs, 1, lane_); rs += shx(rs, 2, lane_); rs += shx(rs, 4, lane_); rs += shx(rs, 8, lane_);
                li[i] = li[i] * alpha + rs; mi[i] = mn;
#pragma unroll
                for (int c = 0; c < 8; ++c) o[i][c] *= alpha;
            }
            __syncthreads();
            for (int key = 0; key < 64; ++key) {
                const u32x4 vv = *(const LAS u32x4*)(Vs + key * 64 + tx * 4);
                float vf[8] = {bf_lo(vv.x), bf_hi(vv.x), bf_lo(vv.y), bf_hi(vv.y), bf_lo(vv.z), bf_hi(vv.z), bf_lo(vv.w), bf_hi(vv.w)};
#pragma unroll
                for (int i = 0; i < 4; ++i) { const float p = Ps[(4 * ty + i) * 65 + key];
#pragma unroll
                    for (int c = 0; c < 8; ++c) o[i][c] += p * vf[c]; }
            }
        }
#pragma unroll
        for (int i = 0; i < 4; ++i) {
            const float inv = 1.f / li[i]; const size_t off = (size_t)(row0 + 4 * ty + i) * 1024 + h * 128 + 8 * tx;
            const u32x4 gg = *(const u32x4*)(Gt + off);
            u32x4 w;
            w.x = cvt_pk_bf16(o[i][0] * inv * bf_lo(gg.x), o[i][1] * inv * bf_hi(gg.x)); w.y = cvt_pk_bf16(o[i][2] * inv * bf_lo(gg.y), o[i][3] * inv * bf_hi(gg.y));
            w.z = cvt_pk_bf16(o[i][4] * inv * bf_lo(gg.z), o[i][5] * inv * bf_hi(gg.z)); w.w = cvt_pk_bf16(o[i][6] * inv * bf_lo(gg.w), o[i][7] * inv * bf_hi(gg.w));
            *(u32x4*)(OG + off) = w;
        }
    }
}


namespace att {
typedef short s16x4 __attribute__((ext_vector_type(4)));
constexpr int SHM_V = 64 * 128 * 2, SHM_K = 64 * 192 * 2, OFF_V = 0, OFF_K = 3 * SHM_V, OFF_WS = OFF_K + 2 * SHM_K;
constexpr float THR2 = 8.f;
#define KSWZ(row, colB) ((((colB) >> 5) * 2048) + (row) * 32 + (((((colB) >> 4) & 1) ^ (((row) >> 3) & 1)) << 4))
#define SBAR() __builtin_amdgcn_sched_barrier(0)
__device__ __forceinline__ int crow(int r, int hi) { return (r & 3) + 8 * (r >> 2) + 4 * hi; }
__device__ __forceinline__ void partialSM(f32x16& p0, f32x16& p1, float& m_reg, float& mn, float& alpha) {
    float pmax = p0[0];
#pragma unroll
    for (int r = 1; r < 16; ++r) pmax = fmaxf(pmax, p0[r]);
#pragma unroll
    for (int r = 0; r < 16; ++r) pmax = fmaxf(pmax, p1[r]);
    { auto rr = __builtin_amdgcn_permlane32_swap(__float_as_uint(pmax), __float_as_uint(pmax), false, false);
      pmax = fmaxf(__uint_as_float(rr[0]), __uint_as_float(rr[1])); }
    if (__builtin_expect(__all(pmax - m_reg <= THR2), 1)) { mn = m_reg; alpha = 1.f; }
    else { mn = fmaxf(m_reg, pmax); alpha = __builtin_amdgcn_exp2f(m_reg - mn); m_reg = mn; }
#pragma unroll
    for (int r = 0; r < 16; ++r) p0[r] = p0[r] - mn;
#pragma unroll
    for (int r = 0; r < 16; ++r) p1[r] = p1[r] - mn;
#pragma unroll
    for (int r = 0; r < 16; ++r) p0[r] = __builtin_amdgcn_exp2f(p0[r]);
}
__device__ __forceinline__ void finishSM(f32x16& p0, f32x16& p1, float alpha, float& l_reg, bf16x8& pa0, bf16x8& pa1, bf16x8& pa2, bf16x8& pa3) {
#pragma unroll
    for (int r = 0; r < 16; ++r) p1[r] = __builtin_amdgcn_exp2f(p1[r]);
    float ps = 0;
#pragma unroll
    for (int r = 0; r < 16; ++r) ps += p0[r];
#pragma unroll
    for (int r = 0; r < 16; ++r) ps += p1[r];
    { auto rr = __builtin_amdgcn_permlane32_swap(__float_as_uint(ps), __float_as_uint(ps), false, false);
      ps = __uint_as_float(rr[0]) + __uint_as_float(rr[1]); }
    l_reg = l_reg * alpha + ps;
#define PK4(P, BASE, OUT) do { unsigned a0 = cvt_pk_bf16(P[BASE + 0], P[BASE + 1]), a1 = cvt_pk_bf16(P[BASE + 2], P[BASE + 3]);   \
    unsigned b0 = cvt_pk_bf16(P[BASE + 4], P[BASE + 5]), b1 = cvt_pk_bf16(P[BASE + 6], P[BASE + 7]);                              \
    auto r0 = __builtin_amdgcn_permlane32_swap(a0, b0, false, false); auto r1 = __builtin_amdgcn_permlane32_swap(a1, b1, false, false); \
    u32x4 w = {r0[0], r1[0], r0[1], r1[1]}; OUT = *reinterpret_cast<bf16x8*>(&w); } while (0)
    PK4(p0, 0, pa0); PK4(p0, 8, pa1); PK4(p1, 0, pa2); PK4(p1, 8, pa3);
#undef PK4
}
__device__ __forceinline__ void qkt(f32x16& p0, f32x16& p1, const char* Ks, const bf16x8* qr, int r32, int hi) {
    p0 = f32x16{}; p1 = f32x16{};
    const char* kb = Ks + r32 * 32 + ((hi ^ ((r32 >> 3) & 1)) << 4);
    bf16x8 ka[4], kc[4];
    __builtin_amdgcn_s_setprio(1);
#pragma unroll
    for (int d0 = 0; d0 < 4; ++d0) { ka[d0] = *reinterpret_cast<const bf16x8*>(kb + d0 * 2048); kc[d0] = *reinterpret_cast<const bf16x8*>(kb + d0 * 2048 + 1024); }
    __builtin_amdgcn_sched_group_barrier(0x100, 8, 0);
#pragma unroll
    for (int d0 = 0; d0 < 12; ++d0) {
        p0 = __builtin_amdgcn_mfma_f32_32x32x16_bf16(ka[d0 & 3], qr[d0], p0, 0, 0, 0);
        p1 = __builtin_amdgcn_mfma_f32_32x32x16_bf16(kc[d0 & 3], qr[d0], p1, 0, 0, 0);
        __builtin_amdgcn_sched_group_barrier(0x8, 2, 0);
        if (d0 + 4 < 12) { ka[d0 & 3] = *reinterpret_cast<const bf16x8*>(kb + (d0 + 4) * 2048); kc[d0 & 3] = *reinterpret_cast<const bf16x8*>(kb + (d0 + 4) * 2048 + 1024);
            __builtin_amdgcn_sched_group_barrier(0x100, 2, 0); }
    }
    __builtin_amdgcn_s_setprio(0);
}
__device__ __forceinline__ int v_st(int k, int c) { const int kk = (k & ~0xC) | ((k & 4) << 1) | ((k & 8) >> 1); return ((kk >> 3) * 4 + (c >> 5)) * 512 + ((kk & 7) * 32 + (c & 31)) * 2; }
__device__ __forceinline__ int v_rd_base(int lane) { return ((lane & 3) << 3) | (((lane >> 2) & 3) << 6) | (((lane >> 4) & 1) << 5) | (((lane >> 5) & 1) << 8); }
constexpr int v_rd_off(int d0, int ks, int half) { return d0 * 512 + ks * 4096 + half * 2048; }
typedef short v4i16_t __attribute__((ext_vector_type(4)));
__device__ __forceinline__ bf16x8 vfrag(const LAS char* p) {
    const v4i16_t l = __builtin_amdgcn_ds_read_tr16_b64_v4i16((LAS v4i16_t*)p), h = __builtin_amdgcn_ds_read_tr16_b64_v4i16((LAS v4i16_t*)(p + 2048));
    return (bf16x8){l[0], l[1], l[2], l[3], h[0], h[1], h[2], h[3]};
}
__device__ __forceinline__ void pv_d0(f32x16* o, int vb, bf16x8 pa0, bf16x8 pa1, bf16x8 pa2, bf16x8 pa3) {
    const LAS char* p = (const LAS char*)(uintptr_t)(unsigned)vb;
    bf16x8 vf[3];
#pragma unroll
    for (int i = 0; i < 3; ++i) vf[i] = vfrag(p + i * 4096);
    __builtin_amdgcn_sched_group_barrier(0x100, 6, 0);
#pragma unroll
    for (int i = 0; i < 16; ++i) {
        const int d0 = i >> 2, ks = i & 3;
        o[d0] = __builtin_amdgcn_mfma_f32_32x32x16_bf16(ks == 0 ? pa0 : ks == 1 ? pa1 : ks == 2 ? pa2 : pa3, vf[i % 3], o[d0], 0, 0, 0);
        __builtin_amdgcn_sched_group_barrier(0x8, 1, 0);
        if (i + 3 < 16) { const int n = i + 3; vf[i % 3] = vfrag(p + (n >> 2) * 512 + (n & 3) * 4096); __builtin_amdgcn_sched_group_barrier(0x100, 2, 0); }
    }
}
template <int VAR>
__device__ __forceinline__ void attn_unit(const bf16_t* __restrict__ Qb, const bf16_t* __restrict__ Kh, const bf16_t* __restrict__ Vh, const bf16_t* Grow, bf16_t* Orow,
                                          int seq, char* lds, bf16x8 (&qr)[12], bf16x8 (&stg)[5], bool pre, bool has_next, const bf16_t* Qn, const bf16_t* Kn, const bf16_t* Vn) {
    const int tid = opaque_tid();
    const int wid = tid >> 6, lane = tid & 63, r32 = lane & 31, hi = lane >> 5;
    char* V_lds = lds + OFF_V; char* K_lds = lds + OFF_K;
    float* wsc = (float*)(lds + OFF_WS) + wid * 64; float* li_l = wsc; float* al_l = wsc + 32;
    float m_reg = -1e30f, l_reg = 0; f32x16 o[4] = {};
    const unsigned qlo = (unsigned)(wid * 32 + r32) * DQK + hi * 8;
    if (!pre) {
#pragma unroll
        for (int d0 = 0; d0 < 12; ++d0) qr[d0] = *reinterpret_cast<const bf16x8*>(Qb + qlo + d0 * 16);
    }
    const int sr = tid >> 4, sc = (tid & 15) * 8, vst0 = v_st(sr, sc), vst1 = v_st(32 + sr, sc);
    const int kr2 = tid >> 3, kc2 = 128 + (tid & 7) * 8;
    const int kst0 = KSWZ(sr, sc * 2), kst1 = KSWZ(32 + sr, sc * 2), kst2 = KSWZ(kr2, kc2 * 2);
    const int vb0 = (int)(uintptr_t)V_lds + v_rd_base(lane);
    bf16x8 &vs0 = stg[0], &vs1 = stg[1], &ks0 = stg[2], &ks1 = stg[3], &ks2 = stg[4];
#define SLOAD(k0) do { vs0 = *(const bf16x8*)(Vh + (unsigned)((k0) + sr) * DV + sc); vs1 = *(const bf16x8*)(Vh + (unsigned)((k0) + 32 + sr) * DV + sc); \
    ks0 = *(const bf16x8*)(Kh + (unsigned)((k0) + sr) * DQK + sc); ks1 = *(const bf16x8*)(Kh + (unsigned)((k0) + 32 + sr) * DQK + sc); ks2 = *(const bf16x8*)(Kh + (unsigned)((k0) + kr2) * DQK + kc2); } while (0)
#define SWRITE(ko_, vo_) do { *(bf16x8*)(V_lds + (vo_) + vst0) = vs0; *(bf16x8*)(V_lds + (vo_) + vst1) = vs1; \
    *(bf16x8*)(K_lds + (ko_) + kst0) = ks0; *(bf16x8*)(K_lds + (ko_) + kst1) = ks1; *(bf16x8*)(K_lds + (ko_) + kst2) = ks2; } while (0)
#define SWAIT() asm volatile("s_waitcnt vmcnt(0)" ::: "memory")
#define RESC(a) do { if (__any((a) < 1.f)) { if (hi == 0) al_l[r32] = (a); asm volatile("s_waitcnt lgkmcnt(0)" ::: "memory"); \
    _Pragma("unroll") for (int d = 0; d < 4; ++d) _Pragma("unroll") for (int r = 0; r < 16; ++r) o[d][r] *= al_l[crow(r, hi)]; } } while (0)
    f32x16 p0, p1; float mn, al; bf16x8 pa0, pa1, pa2, pa3; const int NT = seq / 64;
    const bool lead = wid < 4;
    if (!pre) SLOAD(0);
    SWAIT(); SWRITE(0, 0); __syncthreads();
    SLOAD(64);
    int vo_prev = 0, vo_cur = 0, vo_next = SHM_V;
    for (int j = 0; j < NT; ++j) {
        const int ko = (j & 1) * SHM_K;
        if (!lead && j > 0) pv_d0(o, vb0 + vo_prev, pa0, pa1, pa2, pa3);
        qkt(p0, p1, K_lds + ko, qr, r32, hi);
        __builtin_amdgcn_s_setprio(2); partialSM(p0, p1, m_reg, mn, al); RESC(al);
        finishSM(p0, p1, al, l_reg, pa0, pa1, pa2, pa3); __builtin_amdgcn_s_setprio(0);
        if (j + 1 < NT) { SWAIT(); SWRITE(SHM_K - ko, vo_next); }
        if (j + 2 < NT) SLOAD((j + 2) * 64);
        if (lead) pv_d0(o, vb0 + vo_cur, pa0, pa1, pa2, pa3);
        __syncthreads();
        vo_prev = vo_cur; vo_cur = vo_next; vo_next = (vo_next == 2 * SHM_V) ? 0 : vo_next + SHM_V;
    }
    if (!lead) pv_d0(o, vb0 + vo_prev, pa0, pa1, pa2, pa3);
    if (has_next) {
#pragma unroll
        for (int d0 = 0; d0 < 12; ++d0) qr[d0] = *reinterpret_cast<const bf16x8*>(Qn + qlo + d0 * 16);
        vs0 = *(const bf16x8*)(Vn + (unsigned)(sr) * DV + sc); vs1 = *(const bf16x8*)(Vn + (unsigned)(32 + sr) * DV + sc);
        ks0 = *(const bf16x8*)(Kn + (unsigned)(sr) * DQK + sc); ks1 = *(const bf16x8*)(Kn + (unsigned)(32 + sr) * DQK + sc); ks2 = *(const bf16x8*)(Kn + (unsigned)(kr2) * DQK + kc2);
    }
    if (hi == 0) li_l[r32] = l_reg;
    __syncthreads();
    const int te = opaque_tid(), wide = te >> 6, lanee = te & 63, r32e = te & 31, hie = (te >> 5) & 1;
    const float* lie = (const float*)(lds + OFF_WS) + wide * 64 + 4 * hie;
    unsigned short* ost = (unsigned short*)(lds + wide * 8192) + hie * 4 * 128 + r32e;
#pragma unroll
    for (int r = 0; r < 16; ++r) { const int oc = (r & 3) + 8 * (r >> 2); const float rl = __builtin_amdgcn_rcpf(lie[oc]);
#pragma unroll
        for (int d0 = 0; d0 < 4; ++d0) ost[oc * 128 + d0 * 32] = f2bf(o[d0][r] * rl); }
    asm volatile("s_waitcnt lgkmcnt(0)" ::: "memory");
#pragma unroll
    for (int i = 0; i < 8; ++i) { const int c = lanee + 64 * i, row = c >> 4, ch = c & 15;
        const u32x4 ov = *(const u32x4*)(lds + wide * 8192 + row * 256 + ch * 16);
        const unsigned goff = (unsigned)(wide * 32 + row) * 1024 + ch * 8;
        const u32x4 gv = *(const u32x4*)(Grow + goff);
        u32x4 w;
        w.x = cvt_pk_bf16(bf_lo(ov.x) * bf_lo(gv.x), bf_hi(ov.x) * bf_hi(gv.x)); w.y = cvt_pk_bf16(bf_lo(ov.y) * bf_lo(gv.y), bf_hi(ov.y) * bf_hi(gv.y));
        w.z = cvt_pk_bf16(bf_lo(ov.z) * bf_lo(gv.z), bf_hi(ov.z) * bf_hi(gv.z)); w.w = cvt_pk_bf16(bf_lo(ov.w) * bf_lo(gv.w), bf_hi(ov.w) * bf_hi(gv.w));
        *(u32x4*)(Orow + goff) = w; }
    __syncthreads();
#undef SLOAD
#undef SWRITE
#undef SWAIT
#undef RESC
}
}

template <int VAR>
__device__ __forceinline__ void phase_attn(const Ctx& X, char* lds, bool with_ctx) {
    const bf16_t* Qg = (const bf16_t*)(X.ws + WS_Q); const bf16_t* Kg = (const bf16_t*)(X.ws + WS_K); const bf16_t* Vg = (const bf16_t*)(X.ws + WS_V);
    const bf16_t* Gt = (const bf16_t*)(X.ws + WS_G); bf16_t* OG = (bf16_t*)(X.ws + (VAR ? WS_UR : WS_G));
    bf16x8 qr[12], stg[5];
    if (with_ctx) {
        for (int u = X.bid; u < NB * H; u += X.G) { const int b = u >> 3, h = u & 7, row0 = ML + b * TC;
            att::attn_unit<VAR>(Qg + ((size_t)h * M + row0) * DQK, Kg + (size_t)(b * H + h) * TK * DQK, Vg + (size_t)(b * H + h) * TK * DV,
                           Gt + (size_t)row0 * 1024 + h * 128, OG + (size_t)row0 * 1024 + h * 128, TC, lds, qr, stg, false, false, Qg, Kg, Vg); }
    }
    const int vcu = (X.G % 8 == 0) ? (X.bid % 8) * (X.G / 8) + X.bid / 8 : X.bid;
    bool pre = false;
    for (int u = vcu; u < NB * H * (T / 256); u += X.G) { const int bh = u >> 5, b = bh >> 3, h = bh & 7, row0 = b * T + (u & 31) * 256;
        const int u2 = u + X.G; const bool hn = u2 < NB * H * (T / 256);
        const int bh2 = u2 >> 5, b2 = bh2 >> 3, h2 = bh2 & 7, row2 = b2 * T + (u2 & 31) * 256;
        att::attn_unit<VAR>(Qg + ((size_t)h * M + row0) * DQK, Kg + (size_t)bh * TK * DQK, Vg + (size_t)bh * TK * DV,
                       Gt + (size_t)row0 * 1024 + h * 128, OG + (size_t)row0 * 1024 + h * 128, TK, lds, qr, stg, pre, hn,
                       hn ? Qg + ((size_t)h2 * M + row2) * DQK : Qg, hn ? Kg + (size_t)bh2 * TK * DQK : Kg, hn ? Vg + (size_t)bh2 * TK * DV : Vg);
        pre = hn; }
}


namespace fft {
typedef short v4i16_t __attribute__((ext_vector_type(4)));
using att::s16x4;
__device__ __forceinline__ bf16x8 bfrag(const LAS char* p) {
    const v4i16_t l = __builtin_amdgcn_ds_read_tr16_b64_v4i16((LAS v4i16_t*)p), h = __builtin_amdgcn_ds_read_tr16_b64_v4i16((LAS v4i16_t*)(p + 2048));
    return (bf16x8){l[0], l[1], l[2], l[3], h[0], h[1], h[2], h[3]};
}
}

__device__ __forceinline__ unsigned cvt_pk_vis(float lo, float hi) { return cvt_pk_bf16(lo, hi); }
__device__ __forceinline__ bf16x8 pack8(const f32x16& a, int base) {
    u32x4 w; w.x = cvt_pk_vis(a[base + 0], a[base + 1]); w.y = cvt_pk_vis(a[base + 2], a[base + 3]); w.z = cvt_pk_vis(a[base + 4], a[base + 5]); w.w = cvt_pk_vis(a[base + 6], a[base + 7]);
    return *reinterpret_cast<bf16x8*>(&w);
}
__device__ __forceinline__ void phase_fft1(const Ctx& X, LAS unsigned char* lds) {
    const int tid = opaque_tid(), wid = __builtin_amdgcn_readfirstlane(tid >> 6), lane = tid & 63, r32 = lane & 31, hi = lane >> 5;
    const int nb = wid & 3, mk = wid >> 2;
    const bf16_t* ZC = (const bf16_t*)(X.ws + WS_ZC);
    bf16_t* UR = (bf16_t*)(X.ws + WS_UR); bf16_t* UI = (bf16_t*)(X.ws + WS_UI);
    const bf16_t* A1 = (const bf16_t*)(X.ws + WS_A1); const float* TW = (const float*)(X.ws + WS_TW); const bf16_t* FT = (const bf16_t*)(X.ws + WS_FT);
    bf16x8 aR[8], aI[8];
#pragma unroll
    for (int k = 0; k < 8; ++k) { aR[k] = *(const bf16x8*)(A1 + (mk * 32 + r32) * 128 + k * 16 + hi * 8); aI[k] = *(const bf16x8*)(A1 + (64 + mk * 32 + r32) * 128 + k * 16 + hi * 8); }
    __syncthreads();
#pragma unroll
    for (int i = 0; i < 8; ++i) { const int idx = tid + 512 * i, n = idx >> 4, ch = idx & 15; *(LAS u32x4*)(lds + 16384 + n * 256 + ((ch ^ (n & 15)) << 4)) = *(const u32x4*)(FT + n * 128 + ch * 8); }
    const int zr0 = tid >> 4, zch = tid & 15;
    const int zst0 = zr0 * 256 + ((zch ^ (zr0 & 15)) << 4), zst1 = zst0 + 32 * 256;
    const LAS unsigned char* zrd = lds + r32 * 256;
    const LAS unsigned char* frd = lds + 16384 + (nb * 32 + r32) * 256;
    const int sw = r32 & 15;
    LAS unsigned short* OR_ = (LAS unsigned short*)(lds + 81920); LAS unsigned short* OI_ = (LAS unsigned short*)(lds + 98304);
    bf16x8 c0, c1;
#define F1_LOAD(it) do { const int b_ = (it) >> 10, t2_ = ((it) >> 3) & 127, g_ = (it) & 7; const unsigned o0 = (unsigned)(b_ * T + t2_ + 128 * zr0) * 1024 + g_ * 128 + zch * 8; \
        c0 = *(const bf16x8*)(ZC + o0); c1 = *(const bf16x8*)(ZC + o0 + 32 * 128 * 1024); } while (0)
    int it = X.bid;
    if (it < 4096) F1_LOAD(it);
    for (; it < 4096; it += X.G) {
        const int b = it >> 10, t2 = (it >> 3) & 127, g = it & 7;
        *(LAS bf16x8*)(lds + zst0) = c0; *(LAS bf16x8*)(lds + zst1) = c1;
        __syncthreads();
        if (it + X.G < 4096) F1_LOAD(it + X.G);
        f32x16 zc0 = {}, zc1 = {}, zs0 = {}, zs1 = {};
#pragma unroll
        for (int ks = 0; ks < 8; ++ks) { const int co = ((2 * ks + hi) ^ sw) << 4;
            const bf16x8 a0 = *(const LAS bf16x8*)(zrd + co), a1 = *(const LAS bf16x8*)(zrd + 8192 + co);
            const bf16x8 bc = *(const LAS bf16x8*)(frd + co), bs = *(const LAS bf16x8*)(frd + 32768 + co);
            zc0 = __builtin_amdgcn_mfma_f32_32x32x16_bf16(a0, bc, zc0, 0, 0, 0); zc1 = __builtin_amdgcn_mfma_f32_32x32x16_bf16(a1, bc, zc1, 0, 0, 0);
            zs0 = __builtin_amdgcn_mfma_f32_32x32x16_bf16(a0, bs, zs0, 0, 0, 0); zs1 = __builtin_amdgcn_mfma_f32_32x32x16_bf16(a1, bs, zs1, 0, 0, 0); }
        f32x16 accR = {}, accI = {};
#define F1_STEP(K8, SRC, BASE) do { const bf16x8 B = pack8(SRC, BASE); accR = __builtin_amdgcn_mfma_f32_32x32x16_bf16(aR[K8], B, accR, 0, 0, 0); accI = __builtin_amdgcn_mfma_f32_32x32x16_bf16(aI[K8], B, accI, 0, 0, 0); } while (0)
        F1_STEP(0, zc0, 0); F1_STEP(1, zc0, 8); F1_STEP(2, zc1, 0); F1_STEP(3, zc1, 8);
        F1_STEP(4, zs0, 0); F1_STEP(5, zs0, 8); F1_STEP(6, zs1, 0); F1_STEP(7, zs1, 8);
#undef F1_STEP
        const float* twp = TW + (t2 * 64 + mk * 32 + 4 * hi) * 2;
#pragma unroll
        for (int r = 0; r < 16; ++r) { const int oc = (r & 3) + 8 * (r >> 2); const float c = twp[oc * 2], sn = twp[oc * 2 + 1];
            const float ur = accR[r] * c + accI[r] * sn, ui = accI[r] * c - accR[r] * sn; const int k1 = mk * 32 + oc + 4 * hi;
            OR_[k1 * 128 + nb * 32 + r32] = f2bf(ur); OI_[k1 * 128 + nb * 32 + r32] = f2bf(ui); }
        __syncthreads();
#pragma unroll
        for (int i = 0; i < 2; ++i) { const int c = tid + 512 * i, k1 = c >> 4, ch = c & 15; const unsigned go = (unsigned)(b * T + k1 * 128 + t2) * 1024 + g * 128 + ch * 8;
            *(u32x4*)(UR + go) = *(const LAS u32x4*)(lds + 81920 + k1 * 256 + ch * 16); *(u32x4*)(UI + go) = *(const LAS u32x4*)(lds + 98304 + k1 * 256 + ch * 16); }
    }
#undef F1_LOAD
    __syncthreads();
}
__device__ __forceinline__ void phase_ctx_chan(const Ctx& X, LAS unsigned char* lds) {
    const int tid = opaque_tid();
    bf16_t* ZC = (bf16_t*)(X.ws + WS_ZC); bf16_t* ZS = (bf16_t*)(X.ws + WS_ZS);
    LAS float* zt = (LAS float*)lds; LAS float* cs = zt + 8 * 128; LAS float* sn = cs + 128;
    __syncthreads();
    if (tid < 128) { cs[tid] = cospif(tid * (1.f / 64.f)); sn[tid] = sinpif(tid * (1.f / 64.f)); }
    const int r = tid >> 6, kq = tid & 63;
    for (int it = X.bid; it < 1024; it += X.G) {
        const int rc = it >> 3, g = it & 7;
        __syncthreads();
        { const int idx = tid * 2, row = idx >> 7, c = idx & 127; const unsigned v = *(const unsigned*)(ZC + (unsigned)(ML + rc * 8 + row) * 1024 + g * 128 + c); zt[row * 128 + c] = bf_lo(v); zt[row * 128 + c + 1] = bf_hi(v); }
        __syncthreads();
        float ac0 = 0.f, as0 = 0.f, ac1 = 0.f, as1 = 0.f;
        for (int c = 0; c < 128; ++c) { const float z = zt[r * 128 + c]; const int i0 = (c * 2 * kq) & 127, i1 = (c * (2 * kq + 1)) & 127;
            ac0 += z * cs[i0]; as0 += z * sn[i0]; ac1 += z * cs[i1]; as1 += z * sn[i1]; }
        const unsigned o = (unsigned)(ML + rc * 8 + r) * 1024 + g * 128 + 2 * kq;
        *(unsigned*)(ZC + o) = cvt_pk_bf16(ac0, ac1); *(unsigned*)(ZS + o) = cvt_pk_bf16(as0, as1);
    }
    __syncthreads();
}

__device__ __forceinline__ void fft_store_out(const Ctx& X, LAS unsigned char* lds, int tid, unsigned rowbase, int rstride, int g) {
    const bf16_t* Gt = (const bf16_t*)(X.ws + WS_G); bf16_t* YG = (bf16_t*)(X.ws + WS_G);
#pragma unroll
    for (int i = 0; i < 4; ++i) { const int c = tid + 512 * i, m = c >> 4, ch = c & 15; const unsigned go = (rowbase + (unsigned)(rstride * m)) * 1024 + g * 128 + ch * 8;
        const u32x4 ov = *(const LAS u32x4*)(lds + 65536 + m * 256 + ch * 16); const u32x4 gv = *(const u32x4*)(Gt + go);
        u32x4 w;
        w.x = cvt_pk_bf16(bf_lo(ov.x) * bf_lo(gv.x), bf_hi(ov.x) * bf_hi(gv.x)); w.y = cvt_pk_bf16(bf_lo(ov.y) * bf_lo(gv.y), bf_hi(ov.y) * bf_hi(gv.y));
        w.z = cvt_pk_bf16(bf_lo(ov.z) * bf_lo(gv.z), bf_hi(ov.z) * bf_hi(gv.z)); w.w = cvt_pk_bf16(bf_lo(ov.w) * bf_lo(gv.w), bf_hi(ov.w) * bf_hi(gv.w));
        *(u32x4*)(YG + go) = w; }
}

__device__ __forceinline__ void phase_fft2(const Ctx& X, LAS unsigned char* lds) {
    const int tid = opaque_tid(), wid = __builtin_amdgcn_readfirstlane(tid >> 6), lane = tid & 63, r32 = lane & 31, hi = lane >> 5;
    const int mb = wid & 3, cp = wid >> 2;
    const bf16_t* UR = (const bf16_t*)(X.ws + WS_UR); const bf16_t* UI = (const bf16_t*)(X.ws + WS_UI);
    const bf16_t* A2 = (const bf16_t*)(X.ws + WS_A2);
    bf16x8 a2[16];
#pragma unroll
    for (int k = 0; k < 16; ++k) a2[k] = *(const bf16x8*)(A2 + (mb * 32 + r32) * 256 + k * 16 + hi * 8);
    const int sr = tid >> 4, sc = (tid & 15) * 8, vst0 = att::v_st(sr, sc), vst1 = att::v_st(32 + sr, sc);
    const LAS char* vb = (const LAS char*)lds + att::v_rd_base(lane) + cp * 1024;
    LAS unsigned short* OUT = (LAS unsigned short*)(lds + 65536);
    bf16x8 x0, x1, x2, x3, y0, y1, y2, y3;
#define F2_LOAD(it) do { const int b_ = (it) >> 9, k1_ = ((it) >> 3) & 63, g_ = (it) & 7; const unsigned o0 = (unsigned)(b_ * T + k1_ * 128 + sr) * 1024 + g_ * 128 + sc; \
        x0 = *(const bf16x8*)(UR + o0); x1 = *(const bf16x8*)(UR + o0 + 32 * 1024); x2 = *(const bf16x8*)(UR + o0 + 64 * 1024); x3 = *(const bf16x8*)(UR + o0 + 96 * 1024); \
        y0 = *(const bf16x8*)(UI + o0); y1 = *(const bf16x8*)(UI + o0 + 32 * 1024); y2 = *(const bf16x8*)(UI + o0 + 64 * 1024); y3 = *(const bf16x8*)(UI + o0 + 96 * 1024); } while (0)
    int it = X.bid;
    if (it < 2048) F2_LOAD(it);
    for (; it < 2048; it += X.G) {
        const int b = it >> 9, k1 = (it >> 3) & 63, g = it & 7;
        *(LAS bf16x8*)(lds + vst0) = x0; *(LAS bf16x8*)(lds + vst1) = x1; *(LAS bf16x8*)(lds + 16384 + vst0) = x2; *(LAS bf16x8*)(lds + 16384 + vst1) = x3;
        *(LAS bf16x8*)(lds + 32768 + vst0) = y0; *(LAS bf16x8*)(lds + 32768 + vst1) = y1; *(LAS bf16x8*)(lds + 49152 + vst0) = y2; *(LAS bf16x8*)(lds + 49152 + vst1) = y3;
        __syncthreads();
        if (it + X.G < 2048) F2_LOAD(it + X.G);
        f32x16 acc0 = {}, acc1 = {};
#pragma unroll
        for (int kt = 0; kt < 4; ++kt)
#pragma unroll
            for (int ks = 0; ks < 4; ++ks) { const bf16x8 B0 = fft::bfrag(vb + kt * 16384 + ks * 4096), B1 = fft::bfrag(vb + kt * 16384 + ks * 4096 + 512);
                acc0 = __builtin_amdgcn_mfma_f32_32x32x16_bf16(a2[kt * 4 + ks], B0, acc0, 0, 0, 0); acc1 = __builtin_amdgcn_mfma_f32_32x32x16_bf16(a2[kt * 4 + ks], B1, acc1, 0, 0, 0); }
#pragma unroll
        for (int r = 0; r < 16; ++r) { const int k2 = mb * 32 + (r & 3) + 8 * (r >> 2) + 4 * hi;
            OUT[k2 * 128 + cp * 64 + r32] = f2bf(acc0[r] * (1.f / 1024.f)); OUT[k2 * 128 + cp * 64 + 32 + r32] = f2bf(acc1[r] * (1.f / 1024.f)); }
        __syncthreads();
        fft_store_out(X, lds, tid, (unsigned)(b * T + k1), 64, g);
    }
#undef F2_LOAD
    __syncthreads();
}

__device__ __forceinline__ void phase_fft_ctx(const Ctx& X, LAS unsigned char* lds) {
    const int tid = opaque_tid(), wid = __builtin_amdgcn_readfirstlane(tid >> 6), lane = tid & 63, r32 = lane & 31, hi = lane >> 5;
    const int mb = wid & 3, cp = wid >> 2;
    const bf16_t* ZC = (const bf16_t*)(X.ws + WS_ZC); const bf16_t* ZS = (const bf16_t*)(X.ws + WS_ZS);
    const bf16_t* A3 = (const bf16_t*)(X.ws + WS_A3);
    const int sr = tid >> 4, sc = (tid & 15) * 8, vst0 = att::v_st(sr, sc), vst1 = att::v_st(32 + sr, sc);
    const LAS char* vb = (const LAS char*)lds + att::v_rd_base(lane) + cp * 1024;
    LAS unsigned short* OUT = (LAS unsigned short*)(lds + 65536);
    for (int it = X.bid; it < 64; it += X.G) {
        const int b = it >> 4, kb = (it >> 3) & 1, g = it & 7;
        f32x16 acc0 = {}, acc1 = {};
        for (int half = 0; half < 2; ++half) {
            const bf16_t* Z = half ? ZS : ZC;
            const unsigned o0 = (unsigned)(ML + b * TC + sr) * 1024 + g * 128 + sc;
            __syncthreads();
#pragma unroll
            for (int q = 0; q < 4; ++q) { *(LAS bf16x8*)(lds + q * 16384 + vst0) = *(const bf16x8*)(Z + o0 + (unsigned)(q * 64) * 1024); *(LAS bf16x8*)(lds + q * 16384 + vst1) = *(const bf16x8*)(Z + o0 + (unsigned)(q * 64 + 32) * 1024); }
            __syncthreads();
            const bf16_t* Ar = A3 + (kb * 128 + mb * 32 + r32) * 512 + half * 256 + hi * 8;
#pragma unroll
            for (int kt = 0; kt < 4; ++kt)
#pragma unroll
                for (int ks = 0; ks < 4; ++ks) { const bf16x8 Af = *(const bf16x8*)(Ar + kt * 64 + ks * 16);
                    const bf16x8 B0 = fft::bfrag(vb + kt * 16384 + ks * 4096), B1 = fft::bfrag(vb + kt * 16384 + ks * 4096 + 512);
                    acc0 = __builtin_amdgcn_mfma_f32_32x32x16_bf16(Af, B0, acc0, 0, 0, 0); acc1 = __builtin_amdgcn_mfma_f32_32x32x16_bf16(Af, B1, acc1, 0, 0, 0); }
        }
#pragma unroll
        for (int r = 0; r < 16; ++r) { const int k2 = mb * 32 + (r & 3) + 8 * (r >> 2) + 4 * hi;
            OUT[k2 * 128 + cp * 64 + r32] = f2bf(acc0[r] * 0.005524271728019903f); OUT[k2 * 128 + cp * 64 + 32 + r32] = f2bf(acc1[r] * 0.005524271728019903f); }
        __syncthreads();
        fft_store_out(X, lds, tid, (unsigned)(ML + b * TC + kb * 128), 1, g);
    }
    __syncthreads();
}

__device__ __forceinline__ void phase_dft_naive(const Ctx& X, LAS unsigned char* lds, bool with_ctx) {
    const int tid_ = opaque_tid(), lane_ = tid_ & 63, wave_ = __builtin_amdgcn_readfirstlane(tid_ >> 6); (void)lane_; (void)wave_;

    LAS float* ct = (LAS float*)lds; LAS float* st = ct + 8192;
    LAS unsigned* zcs = (LAS unsigned*)(st + 8192); LAS unsigned* zss = zcs + 64 * 32;
    const bf16_t* ZC = (const bf16_t*)(X.ws + WS_ZC); const bf16_t* ZS = (const bf16_t*)(X.ws + WS_ZS);
    const bf16_t* Gt = (const bf16_t*)(X.ws + WS_G); bf16_t* YG = (bf16_t*)(X.ws + WS_U);
    const int tid = tid_, tx = tid & 15, ty = tid >> 4;
    __syncthreads();
    for (int i = tid; i < 8192; i += 512) { const float x = (float)i * (1.f / 4096.f); ct[i] = cospif(x); st[i] = sinpif(x); }
    const int NI = 4096 + (with_ctx ? 128 : 0);
    for (int it = X.bid; it < NI; it += X.G) {
        int rowbase, k0, c0, Tn, mult; float scale;
        if (it < 4096) { const int b = it >> 10; k0 = ((it >> 4) & 63) * 128; c0 = (it & 15) * 64; rowbase = b * T; Tn = T; mult = 1; scale = 1.f / 1024.f; }
        else { const int ic = it - 4096, b = ic >> 5; k0 = ((ic >> 4) & 1) * 128; c0 = (ic & 15) * 64; rowbase = ML + b * TC; Tn = TC; mult = 32; scale = 0.005524271728019903f; }
        float acc[4][4];
#pragma unroll
        for (int i = 0; i < 4; ++i)
#pragma unroll
            for (int j = 0; j < 4; ++j) acc[i][j] = 0.f;
        const int kb = k0 + 4 * ty;
        for (int t0 = 0; t0 < Tn; t0 += 64) {
            __syncthreads();
            for (int i = 0; i < 4; ++i) { const int idx = tid + 512 * i, r = idx >> 5, c = idx & 31;
                zcs[idx] = ((const unsigned*)(ZC + (size_t)(rowbase + t0 + r) * 1024 + c0))[c];
                zss[idx] = ((const unsigned*)(ZS + (size_t)(rowbase + t0 + r) * 1024 + c0))[c]; }
            __syncthreads();
            for (int tt = 0; tt < 64; ++tt) {
                const int t = t0 + tt;
                const u32x2 zc2 = *(const LAS u32x2*)(zcs + tt * 32 + 2 * tx), zs2 = *(const LAS u32x2*)(zss + tt * 32 + 2 * tx);
                const float zc[4] = {bf_lo(zc2.x), bf_hi(zc2.x), bf_lo(zc2.y), bf_hi(zc2.y)}, zs[4] = {bf_lo(zs2.x), bf_hi(zs2.x), bf_lo(zs2.y), bf_hi(zs2.y)};
#pragma unroll
                for (int i = 0; i < 4; ++i) { const int ix = (((kb + i) * t) * mult) & 8191; const float c = ct[ix], s = st[ix];
#pragma unroll
                    for (int j = 0; j < 4; ++j) acc[i][j] += c * zc[j] - s * zs[j]; }
            }
        }
#pragma unroll
        for (int i = 0; i < 4; ++i) { const size_t off = (size_t)(rowbase + kb + i) * 1024 + c0 + 4 * tx;
            const u32x2 gg = *(const u32x2*)(Gt + off);
            u32x2 w; w.x = cvt_pk_bf16(acc[i][0] * scale * bf_lo(gg.x), acc[i][1] * scale * bf_hi(gg.x)); w.y = cvt_pk_bf16(acc[i][2] * scale * bf_lo(gg.y), acc[i][3] * scale * bf_hi(gg.y));
            *(u32x2*)(YG + off) = w; }
    }
    __syncthreads();
}

template <int LAYER>
__device__ __forceinline__ void run_layer(const Args& a, LAS unsigned char* lds, unsigned char* lds_g, const XcdBarrier& bar) {
    constexpr int P0 = 1 + 5 * LAYER, li = LAYER >> 1;
    constexpr int rows = (LAYER == 3) ? ML : M;
    constexpr int rows_out = (LAYER >= 2) ? ML : M;
#define PH_BEGIN(P) if (a.ph_lo <= (P) && (P) < a.ph_hi) { if ((P) > a.ph_lo) xcd_barrier(bar); const Ctx X(a); unsigned char* ws = X.ws; (void)ws; \
        const float* src_lat = (LAYER == 0) ? X.in[0] : X.out; const float* src_ctx = (LAYER == 0) ? X.in[2] : (const float*)(ws + WS_HC); (void)src_lat; (void)src_ctx; \
        float* HC = (float*)(ws + WS_HC); (void)HC; const float* mod = (const float*)(ws + WS_MOD) + LAYER * 5 * 3072; (void)mod;
#define PH_END }
    if constexpr (LAYER == 0) { PH_BEGIN(P0) phase_norm(X, LAYER, src_lat, src_ctx, rows); PH_END }
    if constexpr ((LAYER & 1) == 0) {
        PH_BEGIN(P0 + 1)
            unsigned char* wb = ws + WS_WMLA + li * WMLA_STRIDE;
            pg8::Gemm g{(const bf16_t*)(ws + WS_U), (const bf16_t*)(wb + WMLA_IN), M, 1536, 1024, 1024, 1024};
            pg8::StaticOrder S; S.init(M, 1536, X.G, X.bid);
            EpiMlaIn E{(bf16_t*)(ws + WS_CQKV), (float*)(ws + WS_SSQ), (bf16_t*)(ws + WS_G), (bf16_t*)(ws + WS_K), (const float*)(ws + WS_ROPE), (const float*)(ws + WS_SSQH), (const float*)(ws + WS_CV) + LAYER * 5 * 3072};
            pg8::gemm_phase(lds, g, S, E);
        PH_END
        PH_BEGIN(P0 + 2)
            unsigned char* wb = ws + WS_WMLA + li * WMLA_STRIDE;
            { pg8::Gemm g{(const bf16_t*)(ws + WS_CQKV), (const bf16_t*)(wb + WMLA_QUP), M, 1536, 256, 512, 256};
              pg8::StaticOrder S; S.init(M, 1536, X.G, X.bid);
              EpiQup E{(bf16_t*)(ws + WS_Q), (const float*)(ws + WS_SSQ), (const float*)(ws + WS_ROPE)};
              pg8::gemm_phase(lds, g, S, E); }
            { pg8::Gemm g{(const bf16_t*)(ws + WS_CQKV) + 256, (const bf16_t*)(wb + WMLA_KVUP), M, 2048, 128, 512, 128};
              pg8::StaticOrder S; S.init(M, 2048, X.G, X.bid);
              EpiKVup E{(bf16_t*)(ws + WS_K), (bf16_t*)(ws + WS_V), (const float*)(ws + WS_SSQ)};
              pg8::gemm_phase(lds, g, S, E); }
        PH_END
        PH_BEGIN(P0 + 3) phase_attn<0>(X, (char*)lds_g, LAYER == 0);
#ifdef PROBE_VAR
            if (LAYER == 0) { __syncthreads(); phase_attn<PROBE_VAR>(X, (char*)lds_g, false); }
#endif
        PH_END
        PH_BEGIN(P0 + 4)
            unsigned char* wb = ws + WS_WMLA + li * WMLA_STRIDE;
            pg8::Gemm g{(const bf16_t*)(ws + WS_G), (const bf16_t*)(wb + WMLA_OUT), rows_out, 1024, 1024, 1024, 1024};
            pg8::StaticOrder S; S.init(rows_out, 1024, X.G, X.bid);
            EpiOut E{src_lat, src_ctx, X.out, HC, mod, (LAYER < 3) ? (const float*)(ws + WS_GS) + (LAYER + 1) * 5 * 1024 : nullptr, (bf16_t*)(ws + WS_U), (float*)(ws + WS_SSQH)};
            pg8::gemm_phase(lds, g, S, E);
        PH_END
    } else {
        PH_BEGIN(P0 + 1)
            unsigned char* wb = ws + WS_WFNO + li * WFNO_STRIDE;
            pg8::Gemm g{(const bf16_t*)(ws + WS_U), (const bf16_t*)(wb + WFNO_IN), rows, 2048, 1024, 1024, 1024};
            pg8::StaticOrder S; S.init(rows, 2048, X.G, X.bid);
            EpiFnoIn E{(bf16_t*)(ws + WS_ZC), (bf16_t*)(ws + WS_ZS), (bf16_t*)(ws + WS_G), (const float*)(ws + WS_SSQH), (const float*)(ws + WS_CV) + LAYER * 5 * 3072};
            pg8::gemm_phase(lds, g, S, E);
        PH_END
        PH_BEGIN(P0 + 2) if (LAYER == 1) phase_ctx_chan(X, lds); phase_fft1(X, lds); PH_END
        PH_BEGIN(P0 + 3) if (LAYER == 1) phase_fft_ctx(X, lds); phase_fft2(X, lds); PH_END
        PH_BEGIN(P0 + 4)
            unsigned char* wb = ws + WS_WFNO + li * WFNO_STRIDE;
            pg8::Gemm g{(const bf16_t*)(ws + WS_G), (const bf16_t*)(wb + WFNO_OUT), rows_out, 1024, 1024, 1024, 1024};
            pg8::StaticOrder S; S.init(rows_out, 1024, X.G, X.bid);
            EpiOut E{src_lat, src_ctx, X.out, HC, mod, (LAYER < 3) ? (const float*)(ws + WS_GS) + (LAYER + 1) * 5 * 1024 : nullptr, (bf16_t*)(ws + WS_U), (float*)(ws + WS_SSQH)};
            pg8::gemm_phase(lds, g, S, E);
        PH_END
    }
}

__global__ void __launch_bounds__(512, 2) mk_fwd(Args a) {
    extern __shared__ __attribute__((aligned(16))) unsigned char lds_raw[];
    LAS unsigned char* lds = (LAS unsigned char*)lds_raw;
    constexpr int LAYER = 0;
    if (a.ph_hi > 100000) cg::this_grid().sync();
    XcdBarrier bar; bar.bar = (unsigned*)a.ws; bar.x = 0; bar.st = (volatile LAS unsigned*)(lds + 131072 + 1024);
    if (a.ph_hi - a.ph_lo > 1) {
        if (threadIdx.x < 16) ((volatile LAS unsigned*)(lds + 131072 + 1024))[threadIdx.x] = 0u;
        __syncthreads();
        bar = xcd_barrier_post((unsigned*)a.ws, (volatile LAS unsigned*)(lds + 131072 + 1024));
    }
    PH_BEGIN(0) phase_prologue(X, lds); PH_END
    run_layer<0>(a, lds, lds_raw, bar);
    run_layer<1>(a, lds, lds_raw, bar);
    run_layer<2>(a, lds, lds_raw, bar);
    run_layer<3>(a, lds, lds_raw, bar);
    PH_BEGIN(NPH - 1) phase_final(X); PH_END
}

extern "C" void kernel_launch(void* const* d_in, const int* in_sizes, int n_in, void* d_out, int out_size, void* d_ws, size_t ws_size, hipStream_t stream) {
    static int grid = 0;
    if (grid == 0) {
        if (n_in != 16 || out_size != ML * D || ws_size < WS_END) { fprintf(stderr, "kernel_launch: unexpected shapes n_in %d out %d ws %zu (need %zu)\n", n_in, out_size, ws_size, (size_t)WS_END); grid = -1; return; }
        int dev = 0, cus = 0, per_cu = 0;
        hipGetDevice(&dev); hipDeviceGetAttribute(&cus, hipDeviceAttributeMultiprocessorCount, dev);
        if (hipFuncSetAttribute((const void*)mk_fwd, hipFuncAttributeMaxDynamicSharedMemorySize, LDS_BYTES) != hipSuccess) { fprintf(stderr, "kernel_launch: hipFuncSetAttribute failed\n"); grid = -1; return; }
        hipOccupancyMaxActiveBlocksPerMultiprocessor(&per_cu, (const void*)mk_fwd, 512, LDS_BYTES);
        if (per_cu < 1) { fprintf(stderr, "kernel_launch: occupancy query says %d blocks per CU\n", per_cu); per_cu = 1; }
        (void)hipGetLastError();
        grid = cus;
    }
    if (grid < 0) return;
    if (hipMemsetAsync(d_ws, 0, 16384, stream) != hipSuccess) { fprintf(stderr, "kernel_launch: memset of the barrier words failed\n"); return; }
    Args a{};
    for (int i = 0; i < 16; ++i) a.in[i] = (const float*)d_in[i];
    a.out = (float*)d_out; a.ws = (unsigned char*)d_ws;
#if MK_SINGLE
    a.ph_lo = 0; a.ph_hi = NPH;
    void* args[] = {&a};
    hipError_t e = hipLaunchCooperativeKernel((const void*)mk_fwd, dim3(grid), dim3(512), args, LDS_BYTES, stream);
    if (e != hipSuccess) fprintf(stderr, "kernel_launch: cooperative launch failed: %s (grid %d)\n", hipGetErrorString(e), grid);
#else
    for (int ph = 0; ph < NPH; ++ph) {
        a.ph_lo = ph; a.ph_hi = ph + 1;
        hipLaunchKernelGGL(mk_fwd, dim3(grid), dim3(512), LDS_BYTES, stream, a);
    }
    const hipError_t le = hipPeekAtLastError();
    if (le != hipSuccess) fprintf(stderr, "kernel_launch: launch failed: %s\n", hipGetErrorName(le));
#endif
}
```
